# Optimizing an MI355X kernel written in HIP

```python
import math
import jax
import jax.numpy as jnp
from jax import lax
import numpy as np

D_MODEL = 1024
BATCH = 2
SEQ = 8192
DEPTH = 4

GRID_W = 64
CTX_LEN = 256
N_MIXERS = 3
N_ATTN_LAYERS = (DEPTH + 2) // N_MIXERS
N_RET_LAYERS = (DEPTH + 1) // N_MIXERS
N_SSM_LAYERS = DEPTH // N_MIXERS
DA_HEADS = 8
DA_HEAD_DIM = D_MODEL // (2 * DA_HEADS)
QUERY_BLOCK = 128
RET_HEADS = 4
RET_KEY_DIM = D_MODEL // RET_HEADS
RET_VAL_DIM = 2 * D_MODEL // RET_HEADS
RET_CHUNK = 128
SSM_GROUP = 16
SSM_GROUPS = D_MODEL // SSM_GROUP
SSM_STATE = 64
DT_MIN = 0.001
DT_MAX = 0.1
FFN_HIDDEN = -(-8 * D_MODEL // (3 * 256)) * 256
ROPE_THETA = 10000.0
NORM_EPS = 1e-6

kernel_name = 'hybrid_diffattn_retention_s5_dit'


def rmsnorm(x, gain):
    xf = x.astype(jnp.float32)
    y = xf * lax.rsqrt(jnp.mean(xf * xf, axis=-1, keepdims=True) + NORM_EPS)
    return (y * gain.astype(jnp.float32)).astype(x.dtype)


def modulate(h, shift, scale):
    return h * (1.0 + scale) + shift


def axial_rope_tables(rows, head_dim):
    quarter = head_dim // 4
    freqs = ROPE_THETA ** (-jnp.arange(quarter, dtype=jnp.float32) / quarter)
    row = jnp.repeat(jnp.arange(rows, dtype=jnp.float32), GRID_W)
    col = jnp.tile(jnp.arange(GRID_W, dtype=jnp.float32), rows)
    ang_r = row[:, None] * freqs
    ang_c = col[:, None] * freqs
    ang = jnp.concatenate([ang_r, ang_r, ang_c, ang_c], axis=-1)
    return jnp.cos(ang), jnp.sin(ang)


def apply_rope(x, cos, sin):
    q4 = x.shape[-1] // 4
    xr = x.reshape(x.shape[:-1] + (2, 2, q4))
    rot = jnp.stack([-xr[..., 1, :], xr[..., 0, :]], axis=-2).reshape(x.shape)
    return x * cos.astype(x.dtype) + rot * sin.astype(x.dtype)


def swiglu(h, w_gate, w_up, w_down):
    return (jax.nn.silu(h @ w_gate) * (h @ w_up)) @ w_down


def diff_softmax_attend(q, k, v, lam):
    s = jnp.einsum('bhiqd,bhikd->bhiqk', q, k, preferred_element_type=jnp.float32)
    p = jax.nn.softmax(s, axis=-1)
    a = p[:, :, 0] - lam * p[:, :, 1]
    return jnp.einsum('bhqk,bhkv->bhqv', a.astype(v.dtype), v, preferred_element_type=jnp.float32)


def diff_attention(hc, hx, w_in, w_out, lam_vec, subln, lam_init, cos, sin, ctx_out):
    bsz, seq, _ = hx.shape
    scale = DA_HEAD_DIM ** -0.5

    def project(h):
        p = h @ w_in
        n = h.shape[1]
        q = p[..., :D_MODEL].reshape(bsz, n, DA_HEADS, 2, DA_HEAD_DIM).transpose(0, 2, 3, 1, 4)
        k = p[..., D_MODEL:2 * D_MODEL].reshape(bsz, n, DA_HEADS, 2, DA_HEAD_DIM).transpose(0, 2, 3, 1, 4)
        v = p[..., 2 * D_MODEL:].reshape(bsz, n, DA_HEADS, 2 * DA_HEAD_DIM).transpose(0, 2, 1, 3)
        return q * scale, k, v

    qc, kc, vc = project(hc)
    qx, kx, vx = project(hx)
    qx = apply_rope(qx, cos, sin)
    kx = apply_rope(kx, cos, sin)
    lv = lam_vec.astype(jnp.float32)
    lam = jnp.exp(jnp.sum(lv[0] * lv[1])) - jnp.exp(jnp.sum(lv[2] * lv[3])) + lam_init

    k_all = jnp.concatenate([kc, kx], axis=3)
    v_all = jnp.concatenate([vc, vx], axis=2)
    nb = seq // QUERY_BLOCK
    qb = jnp.moveaxis(qx.reshape(bsz, DA_HEADS, 2, nb, QUERY_BLOCK, DA_HEAD_DIM), 3, 0)
    ox = lax.map(lambda q: diff_softmax_attend(q, k_all, v_all, lam), qb)
    ox = jnp.moveaxis(ox, 0, 2).reshape(bsz, DA_HEADS, seq, 2 * DA_HEAD_DIM)

    def finish(o):
        n = o.shape[2]
        o = rmsnorm(o, subln) * (1.0 - lam_init)
        return o.transpose(0, 2, 1, 3).reshape(bsz, n, D_MODEL).astype(hx.dtype) @ w_out

    yx = finish(ox)
    yc = finish(diff_softmax_attend(qc, kc, vc, lam)) if ctx_out else None
    return yc, yx


def retention_chunked(q, k, v, log_g, r0):
    bsz, nh, t, _ = q.shape
    dv = v.shape[-1]
    n = t // RET_CHUNK
    idx = jnp.arange(RET_CHUNK, dtype=jnp.float32)
    diff = idx[:, None] - idx[None, :]
    inner_decay = jnp.where(diff >= 0, jnp.exp(log_g[:, None, None] * jnp.maximum(diff, 0.0)), 0.0)
    q_decay = jnp.exp(log_g[:, None] * (idx + 1.0))[..., None]
    k_decay = jnp.exp(log_g[:, None] * (RET_CHUNK - 1.0 - idx))[..., None]
    chunk_decay = jnp.exp(log_g * RET_CHUNK)[:, None, None]

    def to_chunks(z):
        return jnp.moveaxis(z.astype(jnp.float32).reshape(bsz, nh, n, RET_CHUNK, z.shape[-1]), 2, 0)

    def step(r, qkv):
        qc, kc, vc = qkv
        s = jnp.einsum('bhqd,bhkd->bhqk', qc, kc) * inner_decay
        inner = jnp.einsum('bhqk,bhkv->bhqv', s, vc)
        cross = jnp.einsum('bhqd,bhdv->bhqv', qc * q_decay, r)
        r_new = chunk_decay * r + jnp.einsum('bhkd,bhkv->bhdv', kc * k_decay, vc)
        return r_new, inner + cross

    r_fin, out = lax.scan(step, r0, (to_chunks(q), to_chunks(k), to_chunks(v)))
    return jnp.moveaxis(out, 0, 2).reshape(bsz, nh, t, dv), r_fin


def retention(hc, hx, w_in, w_out, decay_logit, cos, sin, ctx_out):
    bsz = hx.shape[0]

    def project(h):
        p = h @ w_in
        n = h.shape[1]
        def heads(z, dh):
            return z.reshape(bsz, n, RET_HEADS, dh).transpose(0, 2, 1, 3)
        q = heads(p[..., :D_MODEL], RET_KEY_DIM)
        k = heads(p[..., D_MODEL:2 * D_MODEL], RET_KEY_DIM) * (RET_KEY_DIM ** -0.5)
        v = heads(p[..., 2 * D_MODEL:4 * D_MODEL], RET_VAL_DIM)
        g = p[..., 4 * D_MODEL:]
        return q, k, v, g

    qc, kc, vc, gc = project(hc)
    qx, kx, vx, gx = project(hx)
    qx = apply_rope(qx, cos, sin)
    kx = apply_rope(kx, cos, sin)
    log_g = jax.nn.log_sigmoid(decay_logit.astype(jnp.float32))
    zero = jnp.zeros((bsz, RET_HEADS, RET_KEY_DIM, RET_VAL_DIM), jnp.float32)

    def flip(z):
        return jnp.flip(z, axis=2)

    oc_f, rc_f = retention_chunked(qc, kc, vc, log_g[0], zero)
    oc_b, rc_b = retention_chunked(flip(qc), flip(kc), flip(vc), log_g[1], zero)
    ox_f, _ = retention_chunked(qx, kx, vx, log_g[0], rc_f)
    ox_b, _ = retention_chunked(flip(qx), flip(kx), flip(vx), log_g[1], rc_b)

    def finish(o, g):
        n = o.shape[2]
        o = o * lax.rsqrt(jnp.mean(o * o, axis=-1, keepdims=True) + NORM_EPS)
        o = o.transpose(0, 2, 1, 3).reshape(bsz, n, RET_HEADS * RET_VAL_DIM).astype(g.dtype)
        return (jax.nn.silu(g) * o) @ w_out

    yx = finish(ox_f + flip(ox_b), gx)
    yc = finish(oc_f + flip(oc_b), gc) if ctx_out else None
    return yc, yx


def ssm_combine(e1, e2):
    a1, b1 = e1
    a2, b2 = e2
    return a1 * a2, a2 * b1 + b2


def ssm_direction(u, lam_bar, b_bar, c_mat, h0, reverse):
    start, end = (-1, 0) if reverse else (0, -1)
    bu = jnp.einsum('btgh,gph->btgp', u, b_bar)
    bu = bu.at[:, start].add(lam_bar * h0)
    a = jnp.broadcast_to(lam_bar, bu.shape)
    _, h = lax.associative_scan(ssm_combine, (a, bu), axis=1, reverse=reverse)
    y = jnp.einsum('btgp,ghp->btgh', h, c_mat).real
    return y, h[:, end]


def s5_mixer(hc, hx, lam_re, lam_im, log_dt, b_re, b_im, c_re, c_im, d_skip, w_glu, ctx_out):
    f32 = jnp.float32
    lam = lax.complex(lam_re.astype(f32), lam_im.astype(f32))
    lam_bar = jnp.exp(lam * jnp.exp(log_dt.astype(f32))[..., None])
    b_bar = ((lam_bar - 1.0) / lam)[..., None] * lax.complex(b_re.astype(f32), b_im.astype(f32))
    c_mat = lax.complex(c_re.astype(f32), c_im.astype(f32))

    def to_groups(h):
        return h.astype(f32).reshape(h.shape[0], h.shape[1], SSM_GROUPS, SSM_GROUP).astype(jnp.complex64)

    u_c, u_x = to_groups(hc), to_groups(hx)
    h0 = jnp.zeros((hx.shape[0], SSM_GROUPS, SSM_STATE), jnp.complex64)
    yc_f, st_f = ssm_direction(u_c, lam_bar[0], b_bar[0], c_mat[0], h0, False)
    yc_b, st_b = ssm_direction(u_c, lam_bar[1], b_bar[1], c_mat[1], h0, True)
    yx_f, _ = ssm_direction(u_x, lam_bar[0], b_bar[0], c_mat[0], st_f, False)
    yx_b, _ = ssm_direction(u_x, lam_bar[1], b_bar[1], c_mat[1], st_b, True)

    def finish(h, y):
        y = y.reshape(h.shape) + d_skip.astype(f32) * h.astype(f32)
        g = jax.nn.gelu(y).astype(h.dtype)
        return (g @ w_glu[:, :D_MODEL]) * jax.nn.sigmoid(g @ w_glu[:, D_MODEL:])

    yx = finish(hx, yx_f + yx_b)
    yc = finish(hc, yc_f + yc_b) if ctx_out else None
    return yc, yx


def setup_inputs(seed: int = 0) -> dict:
    key = jax.random.key(seed)
    ks = jax.random.split(key, 32)
    f32 = jnp.float32
    D = D_MODEL

    def nrm(k, shape, s):
        return jax.random.normal(k, shape, f32) * s

    gamma0 = 1.0 - 2.0 ** (-5.0 - np.arange(RET_HEADS))
    logit0 = jnp.asarray(np.log(gamma0 / (1.0 - gamma0)).astype(np.float32))
    return {
        'x': nrm(ks[0], (BATCH, SEQ, D), 1.0),
        'c': nrm(ks[1], (BATCH, D), 1.0),
        'ctx': nrm(ks[2], (BATCH, CTX_LEN, D), 1.0),
        'c_ctx': nrm(ks[3], (D,), 1.0),
        'mod_w': nrm(ks[4], (DEPTH, D, 6 * D), 0.5 * D ** -0.5),
        'mod_b': nrm(ks[5], (DEPTH, 6 * D), 0.02),
        'norm_g': 1.0 + nrm(ks[6], (DEPTH, 4, D), 0.02),
        'attn_w_in': nrm(ks[7], (N_ATTN_LAYERS, D, 3 * D), D ** -0.5),
        'attn_w_out': nrm(ks[8], (N_ATTN_LAYERS, D, D), D ** -0.5),
        'attn_lambda': nrm(ks[9], (N_ATTN_LAYERS, 4, DA_HEAD_DIM), 0.1),
        'attn_subln': 1.0 + nrm(ks[10], (N_ATTN_LAYERS, 2 * DA_HEAD_DIM), 0.02),
        'ret_w_in': nrm(ks[11], (N_RET_LAYERS, D, 6 * D), D ** -0.5),
        'ret_w_out': nrm(ks[12], (N_RET_LAYERS, 2 * D, D), (2 * D) ** -0.5),
        'ret_decay_logit': logit0 + nrm(ks[13], (N_RET_LAYERS, 2, RET_HEADS), 0.1),
        'ssm_lambda_re': -0.5 + nrm(ks[14], (N_SSM_LAYERS, 2, SSM_GROUPS, SSM_STATE), 0.01),
        'ssm_lambda_im': math.pi * jnp.arange(SSM_STATE, dtype=f32) + nrm(ks[15], (N_SSM_LAYERS, 2, SSM_GROUPS, SSM_STATE), 0.01),
        'ssm_log_dt': jax.random.uniform(ks[16], (N_SSM_LAYERS, 2, SSM_GROUPS), f32, math.log(DT_MIN), math.log(DT_MAX)),
        'ssm_b_re': nrm(ks[17], (N_SSM_LAYERS, 2, SSM_GROUPS, SSM_STATE, SSM_GROUP), (2 * SSM_GROUP) ** -0.5),
        'ssm_b_im': nrm(ks[18], (N_SSM_LAYERS, 2, SSM_GROUPS, SSM_STATE, SSM_GROUP), (2 * SSM_GROUP) ** -0.5),
        'ssm_c_re': nrm(ks[19], (N_SSM_LAYERS, 2, SSM_GROUPS, SSM_GROUP, SSM_STATE), SSM_STATE ** -0.5),
        'ssm_c_im': nrm(ks[20], (N_SSM_LAYERS, 2, SSM_GROUPS, SSM_GROUP, SSM_STATE), SSM_STATE ** -0.5),
        'ssm_d': nrm(ks[21], (N_SSM_LAYERS, D), 1.0),
        'ssm_w_glu': nrm(ks[22], (N_SSM_LAYERS, D, 2 * D), D ** -0.5),
        'ffn_w_gate': nrm(ks[23], (DEPTH, D, FFN_HIDDEN), D ** -0.5),
        'ffn_w_up': nrm(ks[24], (DEPTH, D, FFN_HIDDEN), D ** -0.5),
        'ffn_w_down': nrm(ks[25], (DEPTH, FFN_HIDDEN, D), FFN_HIDDEN ** -0.5),
    }


def reference(x, c, ctx, c_ctx, mod_w, mod_b, norm_g, attn_w_in, attn_w_out, attn_lambda, attn_subln,
              ret_w_in, ret_w_out, ret_decay_logit, ssm_lambda_re, ssm_lambda_im, ssm_log_dt,
              ssm_b_re, ssm_b_im, ssm_c_re, ssm_c_im, ssm_d, ssm_w_glu, ffn_w_gate, ffn_w_up, ffn_w_down):
    bsz, seq, _ = x.shape
    rows = seq // GRID_W
    cos_a, sin_a = axial_rope_tables(rows, DA_HEAD_DIM)
    cos_r, sin_r = axial_rope_tables(rows, RET_KEY_DIM)
    s_lat = jax.nn.silu(c)
    s_ctx = jax.nn.silu(c_ctx)
    h, hc = x, ctx
    for l in range(DEPTH):
        last = l == DEPTH - 1
        m = (s_lat @ mod_w[l] + mod_b[l]).reshape(bsz, 6, 1, D_MODEL)
        mc = (s_ctx @ mod_w[l] + mod_b[l]).reshape(6, 1, D_MODEL)
        ux = modulate(rmsnorm(h, norm_g[l, 0]), m[:, 0], m[:, 1])
        uc = modulate(rmsnorm(hc, norm_g[l, 0]), mc[0], mc[1])
        kind, j = l % N_MIXERS, l // N_MIXERS
        if kind == 0:
            lam_init = 0.8 - 0.6 * math.exp(-0.3 * l)
            yc, yx = diff_attention(uc, ux, attn_w_in[j], attn_w_out[j], attn_lambda[j], attn_subln[j],
                                    lam_init, cos_a, sin_a, not last)
        elif kind == 1:
            yc, yx = retention(uc, ux, ret_w_in[j], ret_w_out[j], ret_decay_logit[j], cos_r, sin_r, not last)
        else:
            yc, yx = s5_mixer(uc, ux, ssm_lambda_re[j], ssm_lambda_im[j], ssm_log_dt[j], ssm_b_re[j],
                              ssm_b_im[j], ssm_c_re[j], ssm_c_im[j], ssm_d[j], ssm_w_glu[j], not last)
        h = h + m[:, 2] * rmsnorm(yx, norm_g[l, 1])
        vx = modulate(rmsnorm(h, norm_g[l, 2]), m[:, 3], m[:, 4])
        h = h + m[:, 5] * rmsnorm(swiglu(vx, ffn_w_gate[l], ffn_w_up[l], ffn_w_down[l]), norm_g[l, 3])
        if not last:
            hc = hc + mc[2] * rmsnorm(yc, norm_g[l, 1])
            vc = modulate(rmsnorm(hc, norm_g[l, 2]), mc[3], mc[4])
            hc = hc + mc[5] * rmsnorm(swiglu(vc, ffn_w_gate[l], ffn_w_up[l], ffn_w_down[l]), norm_g[l, 3])
    return h
```

```cpp
#include <hip/hip_runtime.h>
#include <hip/hip_cooperative_groups.h>
#include <cstdint>
#include <cstdio>
namespace cg = cooperative_groups;

typedef unsigned short bf16;
typedef short bf16x8 __attribute__((ext_vector_type(8)));
typedef short s16x4 __attribute__((ext_vector_type(4)));
typedef float f32x2 __attribute__((ext_vector_type(2)));
typedef float f32x4 __attribute__((ext_vector_type(4)));
typedef float f32x16 __attribute__((ext_vector_type(16)));
typedef unsigned u32x2 __attribute__((ext_vector_type(2)));
typedef unsigned u32x4 __attribute__((ext_vector_type(4)));
typedef __bf16 bf16x2_t __attribute__((ext_vector_type(2)));
#define LAS __attribute__((address_space(3)))
typedef LAS unsigned char* ldsp;
typedef const LAS unsigned char* cldsp;

constexpr int D = 1024, SEQ = 8192, CTX = 256, ML = 16384, MT = 16896, FF = 2816;
constexpr float EPS = 1e-6f;
constexpr float LOG2E = 1.4426950408889634f;

constexpr size_t MiB = 1u << 20;
constexpr size_t WS_MOD = 0;
constexpr size_t WS_ROPEA = 512 * 1024;
constexpr size_t WS_ROPER = WS_ROPEA + 64 * 1024;
constexpr size_t WS_A32 = WS_ROPER + 128 * 1024;
constexpr size_t WS_BAR = 800 * 1024;
constexpr size_t WS_HC = 1 * MiB;
constexpr size_t WS_W = 4 * MiB;
constexpr size_t WS_UY = 40 * MiB;
constexpr size_t WS_P = 76 * MiB;
constexpr size_t WS_HB = WS_P + 264 * MiB;
constexpr size_t WS_END = WS_HB + 34 * MiB;
constexpr size_t W_IN = 0, W_G = 4096 * 1024, W_OUT = 6144 * 1024, W_GU = 8192 * 1024 + 1024 * 1024, W_DN = W_GU + 5632 * 1024;
constexpr size_t P_ATT_O = 100 * MiB;
constexpr size_t P_RET_OF = 132 * MiB, P_RET_OB = 198 * MiB;
constexpr size_t P_S5_O = 0;
constexpr size_t P_S5_M = 100 * MiB;
constexpr size_t P_S5_W = 104 * MiB;
constexpr size_t P_S5_Z = 120 * MiB;
constexpr size_t P_S5_X = 136 * MiB;
constexpr size_t P_S5_H = 170 * MiB;

constexpr int NTHREADS = 512;
constexpr int LDS_BYTES = 160 * 1024;

__device__ __forceinline__ unsigned pk2(float lo, float hi) { f32x2 v = {lo, hi}; bf16x2_t b = __builtin_convertvector(v, bf16x2_t); return __builtin_bit_cast(unsigned, b); }
__device__ __forceinline__ float bflo(unsigned w) { return __uint_as_float(w << 16); }
__device__ __forceinline__ float bfhi(unsigned w) { return __uint_as_float(w & 0xffff0000u); }
__device__ __forceinline__ float wave_sum(float v) {
#pragma unroll
    for (int o = 1; o < 64; o <<= 1) v += __shfl_xor(v, o);
    return v;
}
__device__ __forceinline__ float fexp2(float x) { return __builtin_amdgcn_exp2f(x); }
__device__ __forceinline__ float siluf(float x) { return x / (1.f + fexp2(-x * LOG2E)); }
__device__ __forceinline__ float sigmf(float x) { return 1.f / (1.f + fexp2(-x * LOG2E)); }
__device__ __forceinline__ float gelu_tanh(float x) {
    const float z = 0.7978845608028654f * (x + 0.044715f * x * x * x);
    const float t = fexp2(z * (2.f * LOG2E));
    const float th = 1.f - 2.f / (t + 1.f);
    return 0.5f * x * (1.f + th);
}
__device__ __forceinline__ void sincos_cw(float x, float& s, float& c) {
    const float n = rintf(x * 0.6366197723675814f);
    float r = fmaf(-n, 1.5703125f, x);
    r = fmaf(-n, 4.837512969970703125e-4f, r);
    r = fmaf(-n, 7.54978995489188216e-8f, r);
    const float r2 = r * r;
    const float sp = r + r * r2 * (-1.6666666667e-1f + r2 * (8.3333333333e-3f + r2 * (-1.9841269841e-4f + r2 * 2.7557319224e-6f)));
    const float cp = 1.f + r2 * (-0.5f + r2 * (4.1666666667e-2f + r2 * (-1.3888888889e-3f + r2 * (2.4801587302e-5f + r2 * -2.7557319224e-7f))));
    const int q = ((int)n) & 3;
    s = (q == 0) ? sp : (q == 1) ? cp : (q == 2) ? -sp : -cp;
    c = (q == 0) ? cp : (q == 1) ? -sp : (q == 2) ? -cp : sp;
}
__device__ __forceinline__ f32x16 mfma32(bf16x8 a, bf16x8 b, f32x16 c) { return __builtin_amdgcn_mfma_f32_32x32x16_bf16(a, b, c, 0, 0, 0); }
__device__ __forceinline__ f32x4 mfma16(bf16x8 a, bf16x8 b, f32x4 c) { return __builtin_amdgcn_mfma_f32_16x16x32_bf16(a, b, c, 0, 0, 0); }
typedef short v4i16_t __attribute__((ext_vector_type(4)));
__device__ __forceinline__ s16x4 tr4(cldsp p) { return __builtin_bit_cast(s16x4, __builtin_amdgcn_ds_read_tr16_b64_v4i16((LAS v4i16_t*)p)); }
__device__ __forceinline__ bf16x8 cat8(s16x4 lo, s16x4 hi) { return (bf16x8){lo[0], lo[1], lo[2], lo[3], hi[0], hi[1], hi[2], hi[3]}; }
template <int s8> __device__ __forceinline__ bf16x8 pack8(const f32x16& x) {
    u32x4 p;
    p[0] = pk2(x[s8 + 0], x[s8 + 1]); p[1] = pk2(x[s8 + 2], x[s8 + 3]); p[2] = pk2(x[s8 + 4], x[s8 + 5]); p[3] = pk2(x[s8 + 6], x[s8 + 7]);
    return __builtin_bit_cast(bf16x8, p);
}
__device__ __forceinline__ int crow(int reg, int h) { return (reg & 3) + 8 * (reg >> 2) + 4 * h; }
__device__ __forceinline__ float max3f(float a, float b, float c) { return __builtin_fmaxf(__builtin_fmaxf(a, b), c); }
namespace pg8 {
#define PG8_LAS __attribute__((address_space(3)))
typedef unsigned short bf16_t;
typedef short bf16x8 __attribute__((ext_vector_type(8)));
typedef float f32x4 __attribute__((ext_vector_type(4)));
typedef unsigned u32x4 __attribute__((ext_vector_type(4)));
constexpr int BM = 256, BK = 64, HALF = 128, HTB = HALF * BK * 2  , STAGE_BYTES = 8 * HTB, NXCD = 8, WGM = 8;

__host__ __device__ __forceinline__ int lds_byte(int r, int c) { const int st = (r >> 4) * 2 + (c >> 5), rr = r & 15, cc = c & 31, ob = rr * 64 + cc * 2; return st * 1024 + (ob ^ (((ob >> 9) & 1) << 5)); }
__host__ __device__ __forceinline__ void stage_rc(int b, int& R, int& C) { const int st = b / 1024, sb = b % 1024, swz = sb ^ (((sb >> 9) & 1) << 5); R = (st >> 1) * 16 + swz / 64; C = (st & 1) * 32 + (swz % 64) / 2; }
__host__ __device__ __forceinline__ int perm32(int rho) { const int n = rho >> 4, i = rho & 15; return 8 * (i >> 2) + 4 * n + (i & 3); }

struct Unit { int pm, pn; };
struct Gemm { const bf16_t* A; const bf16_t* Bt; int M, N, K; };

struct StaticOrder {
    int nM, nN, nwg, G, c;
    __host__ __device__ void init(int M, int N, int G_, int c_) { nM = M / BM; nN = N / BM; nwg = nM * nN; G = G_; c = c_; }
    __host__ __device__ bool next(int i, Unit& u) const {
        const long L = (long)i * G + c; if (L >= nwg) return false;
        int wgid = (int)L; { const int q = nwg / NXCD, r = nwg % NXCD, xcd = wgid % NXCD, off = wgid / NXCD; wgid = (xcd < r ? xcd * (q + 1) : r * (q + 1) + (xcd - r) * q) + off; }
        const int nig = WGM * nN, gid = wgid / nig, fm = gid * WGM, gsz = (nM - fm) < WGM ? (nM - fm) : WGM;
        u.pm = fm + ((wgid % nig) % gsz); u.pn = (wgid % nig) / gsz; return true;
    }
    __device__ __forceinline__ void a_ready(const Unit&) const {}
    __device__ __forceinline__ void done(const Unit&) const {}
};
__device__ __forceinline__ unsigned cvt_pk_bf16(float lo, float hi) { unsigned r; asm volatile("v_cvt_pk_bf16_f32 %0, %1, %2" : "=v"(r) : "v"(lo), "v"(hi)); return r; }
template <class Epi, class Sched, bool ALIGN_EPI = false, bool SP2 = false>
__device__ __forceinline__ void gemm_phase(PG8_LAS unsigned char* lds, const Gemm g, const Sched& S, const Epi& E) {
    int tid = threadIdx.x; asm volatile("" : "+v"(tid));
    const int wid = __builtin_amdgcn_readfirstlane(tid >> 6), lane = tid & 63, wr = wid >> 2, wc = wid & 3, fr = lane & 15, fq = lane >> 4;
    const int K = g.K, nt = K / BK;
    unsigned voffA[2], voffB[2];
#pragma unroll
    for (int i = 0; i < 2; ++i) { int R, C; stage_rc(tid * 16 + i * 8192, R, C); const int Rb = Epi::PERM ? ((R & ~31) + perm32(R & 31)) : R;
        voffA[i] = (unsigned)(R * K + C) * 2u; voffB[i] = (unsigned)(Rb * K + C) * 2u; }
    const size_t kstep = (size_t)(BK * 2);
    const size_t hstep = (size_t)HALF * K * 2;
    const size_t tstep = 2 * hstep;
    const unsigned ldsw = (unsigned)wid * 1024u;
    const int aoff = lds_byte(wr * 64 + fr, fq * 8), boff = lds_byte(wc * 32 + fr, fq * 8);
#define PG8_SA(b, h) (((b) * 2 + (h)) * HTB)
#define PG8_SB(b, h) ((4 + (b) * 2 + (h)) * HTB)
#define PG8_STAGE(bufoff, gbase, voff) do { _Pragma("unroll") for (int _i = 0; _i < 2; ++_i) \
        __builtin_amdgcn_global_load_lds((const unsigned*)((const char*)(gbase) + (voff)[_i]), (PG8_LAS unsigned*)(lds + (bufoff) + ldsw + _i * 8192), 16, 0, 0); } while (0)
#define PG8_LDA(dst, b, h) do { _Pragma("unroll") for (int m = 0; m < 4; ++m) _Pragma("unroll") for (int k = 0; k < 2; ++k) dst[m][k] = *(const PG8_LAS bf16x8*)(lds + PG8_SA(b, h) + aoff + m * 2048 + k * 1024); } while (0)
#define PG8_LDB(dst, b, h) do { _Pragma("unroll") for (int n = 0; n < 2; ++n) _Pragma("unroll") for (int k = 0; k < 2; ++k) dst[n][k] = *(const PG8_LAS bf16x8*)(lds + PG8_SB(b, h) + boff + n * 2048 + k * 1024); } while (0)
#define PG8_MMA(ai, bj, At, Bt) do { __builtin_amdgcn_s_setprio(1); _Pragma("unroll") for (int m = 0; m < 4; ++m) _Pragma("unroll") for (int n = 0; n < 2; ++n) _Pragma("unroll") for (int k = 0; k < 2; ++k) \
        acc[ai][bj][m][n] = __builtin_amdgcn_mfma_f32_16x16x32_bf16(Bt[n][k], At[m][k], acc[ai][bj][m][n], 0, 0, 0); __builtin_amdgcn_s_setprio(0); } while (0)
#define PG8_WAIT_V(n) asm volatile("s_waitcnt vmcnt(" #n ")" ::: "memory")
#define PG8_WAIT_L(n) asm volatile("s_waitcnt lgkmcnt(" #n ")" ::: "memory")
#define PG8_BAR __builtin_amdgcn_s_barrier()
#define PG8_SCHED __builtin_amdgcn_sched_barrier(0)
    Unit cur, nxt; int ui = 0;
    if (!S.next(0, cur)) return;
    f32x4 acc[2][2][4][2];
#pragma unroll
    for (int a = 0; a < 2; ++a)
#pragma unroll
        for (int b = 0; b < 2; ++b)
#pragma unroll
            for (int m = 0; m < 4; ++m)
#pragma unroll
                for (int n = 0; n < 2; ++n) acc[a][b][m][n] = (f32x4){0.f, 0.f, 0.f, 0.f};
    bf16x8 At[4][2], B0[2][2], B1[2][2];
    const char* cA = (const char*)g.A + (size_t)cur.pm * tstep; const char* cB = (const char*)g.Bt + (size_t)cur.pn * tstep;
    S.a_ready(cur);
    if constexpr (SP2) {
        PG8_STAGE(PG8_SB(0, 0), cB, voffB); PG8_STAGE(PG8_SB(0, 1), cB + hstep, voffB); PG8_STAGE(PG8_SA(0, 0), cA, voffA); PG8_STAGE(PG8_SA(0, 1), cA + hstep, voffA);
        if (wr == 1) PG8_BAR;
        PG8_WAIT_V(2); PG8_BAR;
        PG8_STAGE(PG8_SB(1, 0), cB + kstep, voffB); PG8_STAGE(PG8_SA(1, 0), cA + kstep, voffA); PG8_STAGE(PG8_SB(1, 1), cB + hstep + kstep, voffB);
        PG8_WAIT_V(6); PG8_BAR;
    } else {
        PG8_STAGE(PG8_SB(0, 0), cB, voffB); PG8_STAGE(PG8_SA(0, 0), cA, voffA); PG8_STAGE(PG8_SB(0, 1), cB + hstep, voffB); PG8_STAGE(PG8_SA(0, 1), cA + hstep, voffA);
        if (wr == 1) PG8_BAR;
        PG8_WAIT_V(4); PG8_BAR;
        PG8_STAGE(PG8_SB(1, 0), cB + kstep, voffB); PG8_STAGE(PG8_SA(1, 0), cA + kstep, voffA); PG8_STAGE(PG8_SB(1, 1), cB + hstep + kstep, voffB);
        PG8_WAIT_V(6); PG8_BAR;
    }
    for (;;) {
        const bool has_next = S.next(ui + 1, nxt);
        const char* nA = has_next ? (const char*)g.A + (size_t)nxt.pm * tstep : cA; const char* nB = has_next ? (const char*)g.Bt + (size_t)nxt.pn * tstep : cB;
        for (int t = 0; t < nt; t += 2) {
            const bool last = (t == nt - 2);
            const char* a1 = cA + (size_t)(t + 1) * kstep;
            const char* a2 = last ? nA : cA + (size_t)(t + 2) * kstep; const char* b2 = last ? nB : cB + (size_t)(t + 2) * kstep;
            const char* a3 = a2 + kstep; const char* b3 = b2 + kstep;
            if (last && has_next) S.a_ready(nxt);
            if constexpr (SP2) {
            PG8_LDB(B0, 0, 0); PG8_LDB(B1, 0, 1); PG8_SCHED; PG8_LDA(At, 0, 0); PG8_STAGE(PG8_SA(1, 1), a1 + hstep, voffA);
            PG8_WAIT_V(8); PG8_WAIT_L(0); PG8_BAR; PG8_MMA(0, 0, At, B0); PG8_MMA(0, 1, At, B1); PG8_BAR; PG8_SCHED;
            PG8_LDA(At, 0, 1); PG8_STAGE(PG8_SB(0, 0), b2, voffB); PG8_STAGE(PG8_SB(0, 1), b2 + hstep, voffB); PG8_STAGE(PG8_SA(0, 0), a2, voffA);
            PG8_WAIT_V(8); PG8_WAIT_L(0); PG8_BAR; PG8_MMA(1, 0, At, B0); PG8_MMA(1, 1, At, B1); PG8_BAR; PG8_SCHED;
            PG8_LDB(B0, 1, 0); PG8_LDB(B1, 1, 1); PG8_SCHED; PG8_LDA(At, 1, 0); PG8_STAGE(PG8_SA(0, 1), a2 + hstep, voffA);
            PG8_WAIT_V(8); PG8_WAIT_L(0); PG8_BAR; PG8_MMA(0, 0, At, B0); PG8_MMA(0, 1, At, B1); PG8_BAR; PG8_SCHED;
            PG8_LDA(At, 1, 1); PG8_STAGE(PG8_SB(1, 0), b3, voffB); PG8_STAGE(PG8_SB(1, 1), b3 + hstep, voffB); PG8_STAGE(PG8_SA(1, 0), a3, voffA);
            PG8_WAIT_V(8); PG8_WAIT_L(0); PG8_BAR; PG8_MMA(1, 0, At, B0); PG8_MMA(1, 1, At, B1); PG8_BAR; PG8_SCHED;
            } else {
            PG8_LDB(B0, 0, 0); PG8_SCHED; PG8_LDA(At, 0, 0); PG8_STAGE(PG8_SA(1, 1), a1 + hstep, voffA);
            PG8_WAIT_L(8); PG8_BAR; PG8_WAIT_L(0); PG8_MMA(0, 0, At, B0); PG8_BAR; PG8_SCHED;
            PG8_LDB(B1, 0, 1); PG8_STAGE(PG8_SB(0, 0), b2, voffB);
            PG8_BAR; PG8_WAIT_L(0); PG8_MMA(0, 1, At, B1); PG8_BAR;
            PG8_LDA(At, 0, 1); PG8_STAGE(PG8_SA(0, 0), a2, voffA);
            PG8_BAR; PG8_WAIT_L(0); PG8_MMA(1, 0, At, B0); PG8_BAR; PG8_SCHED;
            PG8_STAGE(PG8_SB(0, 1), b2 + hstep, voffB);
            PG8_WAIT_V(6); PG8_BAR; PG8_MMA(1, 1, At, B1); PG8_BAR;
            PG8_LDB(B0, 1, 0); PG8_SCHED; PG8_LDA(At, 1, 0); PG8_STAGE(PG8_SA(0, 1), a2 + hstep, voffA);
            PG8_WAIT_L(8); PG8_BAR; PG8_WAIT_L(0); PG8_MMA(0, 0, At, B0); PG8_BAR; PG8_SCHED;
            PG8_LDB(B1, 1, 1); PG8_STAGE(PG8_SB(1, 0), b3, voffB);
            PG8_BAR; PG8_WAIT_L(0); PG8_MMA(0, 1, At, B1); PG8_BAR;
            PG8_LDA(At, 1, 1); PG8_STAGE(PG8_SA(1, 0), a3, voffA);
            PG8_BAR; PG8_WAIT_L(0); PG8_MMA(1, 0, At, B0); PG8_BAR; PG8_SCHED;
            PG8_STAGE(PG8_SB(1, 1), b3 + hstep, voffB);
            PG8_WAIT_V(6); PG8_BAR; PG8_MMA(1, 1, At, B1); PG8_BAR;
            }
        }
        if constexpr (ALIGN_EPI) { if (wr == 0) PG8_BAR; }
        if constexpr (!Epi::AFTER_DRAIN) { E(acc, cur, wr, wc, fr, fq); S.done(cur); }
        if (!has_next) break;
#pragma unroll
        for (int a = 0; a < 2; ++a)
#pragma unroll
            for (int b = 0; b < 2; ++b)
#pragma unroll
                for (int m = 0; m < 4; ++m)
#pragma unroll
                    for (int n = 0; n < 2; ++n) acc[a][b][m][n] = (f32x4){0.f, 0.f, 0.f, 0.f};
        cur = nxt; cA = nA; cB = nB; ++ui;
        if constexpr (ALIGN_EPI) { if (wr == 1) PG8_BAR; }
    }
    PG8_WAIT_V(0);
    if constexpr (!ALIGN_EPI) { if (wr == 0) PG8_BAR; }
    PG8_BAR;
    if constexpr (Epi::AFTER_DRAIN) { E.fused(acc, cur, wr, wc, fr, fq, lds, wid, lane); S.done(cur); }
#undef PG8_SA
#undef PG8_SB
#undef PG8_STAGE
#undef PG8_LDA
#undef PG8_LDB
#undef PG8_MMA
#undef PG8_WAIT_V
#undef PG8_WAIT_L
#undef PG8_BAR
#undef PG8_SCHED
}
}
#define XB_TMO      128
#define XB_XCNT(j)  (256  + 64 * (j))
#define XB_XSUB(j)  (1280 + 64 * (j))
#define XB_XGEN(j)  (2304 + 64 * (j))
#define XB_TOP      3328
#define XB_TOPGEN   3392
#define XCD_BAR_WORDS 3456
#define XB_SPIN_CAP (1u << 18)

__device__ __forceinline__ unsigned xb_ld(unsigned* p)              { return __hip_atomic_load(p, __ATOMIC_RELAXED, __HIP_MEMORY_SCOPE_AGENT); }
__device__ __forceinline__ unsigned xb_add(unsigned* p, unsigned v) { return __hip_atomic_fetch_add(p, v, __ATOMIC_RELAXED, __HIP_MEMORY_SCOPE_AGENT); }
__device__ __forceinline__ unsigned xb_xcc_id() { return (unsigned)__builtin_amdgcn_s_getreg((3 << 11) | 20) & 0xFu; }
#define XB_SPIN(cond, bar) do { unsigned _sp = 0; while (cond) { __builtin_amdgcn_s_sleep(1); \
    if ((++_sp & 255u) == 0u) { if (xb_ld(&(bar)[XB_TMO])) break; if (_sp > XB_SPIN_CAP) { atomicAdd(&(bar)[XB_TMO], 1u); break; } } } } while (0)

struct XcdBarrier {
    unsigned* bar; unsigned x;
    volatile LAS unsigned* st;
};

__device__ __forceinline__ XcdBarrier xcd_barrier_post(unsigned* bar, volatile LAS unsigned* st) {
    XcdBarrier b; b.bar = bar; b.x = xb_xcc_id(); b.st = st;
    if (threadIdx.x == 0) (void)xb_add(&bar[XB_XCNT(b.x)], 1u);
    return b;
}
__device__ __forceinline__ void xcd_barrier_complete(unsigned* bar, unsigned x, unsigned& nloc, unsigned& nx) {
    const unsigned G = gridDim.x * gridDim.y * gridDim.z;
    unsigned sum, cnt, mine, sp = 0u;
    for (;;) {
        sum = 0u; cnt = 0u; mine = 0u;
#pragma unroll
        for (unsigned j = 0; j < 16; ++j) { const unsigned c = xb_ld(&bar[XB_XCNT(j)]); sum += c; cnt += (c > 0u) ? 1u : 0u; mine = (j == x) ? c : mine; }
        if (sum == G) break;
        __builtin_amdgcn_s_sleep(1);
        if ((++sp & 255u) == 0u) { if (xb_ld(&bar[XB_TMO])) break; if (sp > XB_SPIN_CAP) { atomicAdd(&bar[XB_TMO], 1u); break; } }
    }
    nloc = mine > 0u ? mine : 1u; nx = cnt > 0u ? cnt : 1u;
}

__device__ __forceinline__ void xcd_barrier(const XcdBarrier& b) {
    asm volatile("s_waitcnt vmcnt(0)" ::: "memory");
    __syncthreads();
    if (threadIdx.x == 0) {
        unsigned* bar = b.bar;
        __builtin_amdgcn_s_waitcnt(0);
        unsigned nloc = b.st[0], nx = b.st[1];
        if (nloc == 0u) { xcd_barrier_complete(bar, b.x, nloc, nx); b.st[0] = nloc; b.st[1] = nx; }
        const unsigned old = xb_add(&bar[XB_XSUB(b.x)], 1u);
        const unsigned gen = old / nloc;
        if (old + 1u == (gen + 1u) * nloc) {
            __builtin_amdgcn_fence(__ATOMIC_RELEASE, "agent");
            asm volatile("s_waitcnt vmcnt(0)" ::: "memory");
            const unsigned og = xb_add(&bar[XB_TOP], 1u);
            const unsigned tg = og / nx;
            if (og + 1u == (tg + 1u) * nx) xb_add(&bar[XB_TOPGEN], 1u);
            else XB_SPIN(xb_ld(&bar[XB_TOPGEN]) == tg, bar);
            __builtin_amdgcn_fence(__ATOMIC_ACQUIRE, "agent");
            xb_add(&bar[XB_XGEN(b.x)], 1u);
            asm volatile("s_waitcnt vmcnt(0)" ::: "memory");
        } else {
            XB_SPIN(xb_ld(&bar[XB_XGEN(b.x)]) == gen, bar);
            __builtin_amdgcn_fence(__ATOMIC_ACQUIRE, "agent");
            asm volatile("s_waitcnt vmcnt(0)" ::: "memory");
        }
    }
    __syncthreads();
}


typedef f32x4 acc_t[2][2][4][2];

struct EpiStore {
    static constexpr bool PERM = true, AFTER_DRAIN = false;
    bf16* O; int ldc;
    __device__ __forceinline__ void operator()(const acc_t& acc, const pg8::Unit& u, int wr, int wc, int fr, int fq) const {
        const int row0 = u.pm * 256 + wr * 64 + fr, col0 = u.pn * 256 + wc * 32 + 8 * fq;
#pragma unroll
        for (int ai = 0; ai < 2; ++ai)
#pragma unroll
            for (int m = 0; m < 4; ++m) {
                bf16* rowp = O + (size_t)(row0 + ai * 128 + m * 16) * ldc + col0;
#pragma unroll
                for (int bj = 0; bj < 2; ++bj) {
                    const f32x4 v0 = acc[ai][bj][m][0], v1 = acc[ai][bj][m][1];
                    u32x4 w; w.x = pk2(v0[0], v0[1]); w.y = pk2(v0[2], v0[3]); w.z = pk2(v1[0], v1[1]); w.w = pk2(v1[2], v1[3]);
                    *(u32x4*)(rowp + bj * 128) = w;
                }
            }
    }
};
struct EpiRetGate {
    static constexpr bool PERM = true, AFTER_DRAIN = false;
    bf16* O; int ldc;
    __device__ __forceinline__ void operator()(const acc_t& acc, const pg8::Unit& u, int wr, int wc, int fr, int fq) const {
        const int row0 = u.pm * 256 + wr * 64 + fr, col0 = u.pn * 256 + wc * 32 + 8 * fq;
#pragma unroll
        for (int ai = 0; ai < 2; ++ai)
#pragma unroll
            for (int m = 0; m < 4; ++m) {
                bf16* rowp = O + (size_t)(row0 + ai * 128 + m * 16) * ldc + col0;
#pragma unroll
                for (int bj = 0; bj < 2; ++bj) {
                    const f32x4 v0 = acc[ai][bj][m][0], v1 = acc[ai][bj][m][1];
                    const u32x4 o = *(const u32x4*)(rowp + bj * 128);
                    u32x4 w;
                    w.x = pk2(siluf(v0[0]) * bflo(o.x), siluf(v0[1]) * bfhi(o.x)); w.y = pk2(siluf(v0[2]) * bflo(o.y), siluf(v0[3]) * bfhi(o.y));
                    w.z = pk2(siluf(v1[0]) * bflo(o.z), siluf(v1[1]) * bfhi(o.z)); w.w = pk2(siluf(v1[2]) * bflo(o.w), siluf(v1[3]) * bfhi(o.w));
                    *(u32x4*)(rowp + bj * 128) = w;
                }
            }
    }
};
template <int ACT  > struct EpiPair {
    static constexpr bool PERM = false, AFTER_DRAIN = false;
    bf16* O; int ldc;
    __device__ __forceinline__ void operator()(const acc_t& acc, const pg8::Unit& u, int wr, int wc, int fr, int fq) const {
        const int row0 = u.pm * 256 + wr * 64 + fr;
#pragma unroll
        for (int ai = 0; ai < 2; ++ai)
#pragma unroll
            for (int m = 0; m < 4; ++m) {
                bf16* rowp = O + (size_t)(row0 + ai * 128 + m * 16) * ldc;
#pragma unroll
                for (int bj = 0; bj < 2; ++bj) {
                    const int col = 16 * (u.pn * 8 + 4 * bj + wc) + 4 * fq;
                    const f32x4 a = acc[ai][bj][m][0], b = acc[ai][bj][m][1];
                    float t[4];
#pragma unroll
                    for (int e = 0; e < 4; ++e) t[e] = (ACT == 0) ? siluf(a[e]) * b[e] : a[e] * sigmf(b[e]);
                    u32x2 w; w.x = pk2(t[0], t[1]); w.y = pk2(t[2], t[3]);
                    *(u32x2*)(rowp + col) = w;
                }
            }
    }
};
struct EpiAttnIn {
    static constexpr bool PERM = false, AFTER_DRAIN = false;
    bf16* O; const float* rope;
    __device__ __forceinline__ void operator()(const acc_t& acc, const pg8::Unit& u, int wr, int wc, int fr, int fq) const {
        const int row0 = u.pm * 256 + wr * 64 + fr, part = u.pn >> 2;
        const bool lat = u.pm < 64;
        const float sc = (part == 0) ? 0.125f * LOG2E : 1.f;
#pragma unroll
        for (int ai = 0; ai < 2; ++ai)
#pragma unroll
            for (int m = 0; m < 4; ++m) {
                const int row = row0 + ai * 128 + m * 16;
                bf16* rowp = O + (size_t)row * 3072 + u.pn * 256 + wc * 32 + 4 * fq;
                f32x4 cs0 = {1.f, 0.f, 1.f, 0.f}, cs1 = {1.f, 0.f, 1.f, 0.f};
                if (part < 2 && lat) {
                    const int s = row & 8191, pos = (wc & 1) ? (s & 63) : (s >> 6);
                    const f32x4* tp = (const f32x4*)(rope + (size_t)(pos * 16 + 4 * fq) * 2);
                    cs0 = tp[0]; cs1 = tp[1];
                }
#pragma unroll
                for (int bj = 0; bj < 2; ++bj) {
                    const f32x4 x0 = acc[ai][bj][m][0], x1 = acc[ai][bj][m][1];
                    f32x4 o0, o1;
                    if (part < 2) {
                        const float c[4] = {cs0[0], cs0[2], cs1[0], cs1[2]}, sn[4] = {cs0[1], cs0[3], cs1[1], cs1[3]};
#pragma unroll
                        for (int e = 0; e < 4; ++e) { o0[e] = (x0[e] * c[e] - x1[e] * sn[e]) * sc; o1[e] = (x1[e] * c[e] + x0[e] * sn[e]) * sc; }
                    } else { o0 = x0; o1 = x1; }
                    u32x2 w0, w1; w0.x = pk2(o0[0], o0[1]); w0.y = pk2(o0[2], o0[3]); w1.x = pk2(o1[0], o1[1]); w1.y = pk2(o1[2], o1[3]);
                    *(u32x2*)(rowp + bj * 128) = w0; *(u32x2*)(rowp + bj * 128 + 16) = w1;
                }
            }
    }
};
struct EpiRetIn {
    static constexpr bool PERM = false, AFTER_DRAIN = false;
    bf16* O; const float* rope;
    __device__ __forceinline__ void operator()(const acc_t& acc, const pg8::Unit& u, int wr, int wc, int fr, int fq) const {
        const int row0 = u.pm * 256 + wr * 64 + fr, part = u.pn >> 2;
        const bool lat = u.pm < 64;
        const float sc = (part == 1) ? 0.0625f : 1.f;
#pragma unroll
        for (int ai = 0; ai < 2; ++ai)
#pragma unroll
            for (int m = 0; m < 4; ++m) {
                const int row = row0 + ai * 128 + m * 16;
                bf16* rowp = O + (size_t)row * 4096 + u.pn * 256 + wc * 32 + 4 * fq;
                const int s = row & 8191;
#pragma unroll
                for (int bj = 0; bj < 2; ++bj) {
                    const f32x4 x0 = acc[ai][bj][m][0], x1 = acc[ai][bj][m][1];
                    f32x4 o0, o1;
                    if (part < 2) {
                        f32x4 cs0 = {1.f, 0.f, 1.f, 0.f}, cs1 = {1.f, 0.f, 1.f, 0.f};
                        if (lat) {
                            const int pos = bj ? (s & 63) : (s >> 6);
                            const f32x4* tp = (const f32x4*)(rope + (size_t)(pos * 64 + 16 * wc + 4 * fq) * 2);
                            cs0 = tp[0]; cs1 = tp[1];
                        }
                        const float c[4] = {cs0[0], cs0[2], cs1[0], cs1[2]}, sn[4] = {cs0[1], cs0[3], cs1[1], cs1[3]};
#pragma unroll
                        for (int e = 0; e < 4; ++e) { o0[e] = (x0[e] * c[e] - x1[e] * sn[e]) * sc; o1[e] = (x1[e] * c[e] + x0[e] * sn[e]) * sc; }
                    } else { o0 = x0; o1 = x1; }
                    u32x2 w0, w1; w0.x = pk2(o0[0], o0[1]); w0.y = pk2(o0[2], o0[3]); w1.x = pk2(o1[0], o1[1]); w1.y = pk2(o1[2], o1[3]);
                    *(u32x2*)(rowp + bj * 128) = w0; *(u32x2*)(rowp + bj * 128 + 16) = w1;
                }
            }
    }
};

template <class Epi> __device__ __forceinline__ void run_gemm(ldsp lds, const bf16* A, const bf16* Bt, int Mrows, int N, int K, const Epi& E) {
    pg8::Gemm g{A, Bt, Mrows, N, K}; pg8::StaticOrder S; S.init(Mrows, N, (int)gridDim.x, (int)blockIdx.x);
    pg8::gemm_phase<Epi, pg8::StaticOrder, true, true>(lds, g, S, E);
}

__device__ __forceinline__ int dest_row(int mode, int half, int c) {
    if (mode == 1) return 32 * (c >> 4) + 16 * half + (c & 15);
    if (mode == 2 && c < 2048) { const int cl = c & 255, seg = cl >> 7, hf = (cl >> 6) & 1, j = cl & 63; return (c - cl) + 32 * (seg * 4 + (j >> 4)) + 16 * hf + (j & 15); }
    return c;
}
__device__ __forceinline__ void conv_w(const float* __restrict__ W, int ldw, int K, int ncols, bf16* __restrict__ WT, int mode, int half, ldsp lds, int gw, int ngw, int lane, int wave) {
    LAS float* scr = (LAS float*)(lds + wave * 16384);
    const int nblk = ncols / 32, nitems = (K / 64) * nblk;
    for (int it = gw; it < nitems; it += ngw) {
        const int kb = it / nblk, nb = it % nblk, k0 = 64 * kb, n0 = 32 * nb;
        float wv[32];
#pragma unroll
        for (int i = 0; i < 32; ++i) wv[i] = W[(size_t)(k0 + 2 * i + (lane >> 5)) * ldw + n0 + (lane & 31)];
#pragma unroll
        for (int i = 0; i < 32; ++i) scr[(2 * i + (lane >> 5)) * 33 + (lane & 31)] = wv[i];
        asm volatile("s_waitcnt lgkmcnt(0)" ::: "memory");
        const int c = lane & 7;
#pragma unroll
        for (int j = 0; j < 4; ++j) {
            const int n = (lane >> 3) + 8 * j; const LAS float* s = scr + (8 * c) * 33 + n;
            u32x4 o; o.x = pk2(s[0 * 33], s[1 * 33]); o.y = pk2(s[2 * 33], s[3 * 33]); o.z = pk2(s[4 * 33], s[5 * 33]); o.w = pk2(s[6 * 33], s[7 * 33]);
            *(u32x4*)(WT + (size_t)dest_row(mode, half, n0 + n) * K + k0 + 8 * c) = o;
        }
        asm volatile("s_waitcnt lgkmcnt(0)" ::: "memory");
    }
}

struct Params { const float* in[26]; float* out; unsigned char* ws; int ph_lo, ph_hi; };
enum { I_X = 0, I_C, I_CTX, I_CCTX, I_MODW, I_MODB, I_NORMG, I_AWIN, I_AWOUT, I_ALAM, I_ASUBLN, I_RWIN, I_RWOUT, I_RDECAY, I_SLRE, I_SLIM, I_SLOGDT,
       I_SBRE, I_SBIM, I_SCRE, I_SCIM, I_SD, I_SWGLU, I_FWG, I_FWU, I_FWD };

__device__ __forceinline__ void conv_layer(const Params& p, int l, ldsp lds, int gw, int ngw, int lane, int wave) {
    bf16* Wb = (bf16*)(p.ws + WS_W);
    const int kind = l % 3, j = l / 3;
    if (kind == 0) {
        conv_w(p.in[I_AWIN] + (size_t)j * D * 3072, 3072, D, 3072, Wb + W_IN, 0, 0, lds, gw, ngw, lane, wave);
        conv_w(p.in[I_AWOUT] + (size_t)j * D * D, D, D, D, Wb + W_OUT, 0, 0, lds, gw, ngw, lane, wave);
    } else if (kind == 1) {
        conv_w(p.in[I_RWIN], 6144, D, 4096, Wb + W_IN, 2, 0, lds, gw, ngw, lane, wave);
        conv_w(p.in[I_RWIN] + 4096, 6144, D, 2048, Wb + W_G, 0, 0, lds, gw, ngw, lane, wave);
        conv_w(p.in[I_RWOUT], D, 2048, D, Wb + W_OUT, 0, 0, lds, gw, ngw, lane, wave);
    } else {
        conv_w(p.in[I_SWGLU], 2048, D, 1024, Wb + W_OUT, 1, 0, lds, gw, ngw, lane, wave);
        conv_w(p.in[I_SWGLU] + 1024, 2048, D, 1024, Wb + W_OUT, 1, 1, lds, gw, ngw, lane, wave);
    }
    conv_w(p.in[I_FWG] + (size_t)l * D * FF, FF, D, FF, Wb + W_GU, 1, 0, lds, gw, ngw, lane, wave);
    conv_w(p.in[I_FWU] + (size_t)l * D * FF, FF, D, FF, Wb + W_GU, 1, 1, lds, gw, ngw, lane, wave);
    conv_w(p.in[I_FWD] + (size_t)l * FF * D, D, FF, D, Wb + W_DN, 0, 0, lds, gw, ngw, lane, wave);
}

__device__ __forceinline__ void mods_phase(const Params& p, ldsp lds, int tid) {
    LAS float* sil = (LAS float*)lds;
    LAS float* red = sil + 3 * 1024;
    for (int i = tid; i < 3072; i += NTHREADS) { const float v = (i < 2048) ? p.in[I_C][i] : p.in[I_CCTX][i - 2048]; sil[i] = siluf(v); }
    __syncthreads();
    float* modv = (float*)(p.ws + WS_MOD);
    const int ks = tid >> 6, c = tid & 63;
    for (int u = blockIdx.x; u < 4 * 96; u += gridDim.x) {
        const int l = u / 96, col = (u % 96) * 64 + c;
        const float* w = p.in[I_MODW] + (size_t)l * D * 6144 + col;
        float a0 = 0.f, a1 = 0.f, a2 = 0.f;
#pragma unroll 1
        for (int kb = ks * 128; kb < ks * 128 + 128; kb += 32) {
            float wq[32];
#pragma unroll
            for (int i = 0; i < 32; ++i) wq[i] = w[(size_t)(kb + i) * 6144];
#pragma unroll
            for (int i = 0; i < 32; ++i) { a0 += sil[kb + i] * wq[i]; a1 += sil[1024 + kb + i] * wq[i]; a2 += sil[2048 + kb + i] * wq[i]; }
        }
        red[(ks * 3 + 0) * 64 + c] = a0; red[(ks * 3 + 1) * 64 + c] = a1; red[(ks * 3 + 2) * 64 + c] = a2;
        __syncthreads();
        if (tid < 192) {
            const int set = tid >> 6; float s = 0.f;
#pragma unroll
            for (int k = 0; k < 8; ++k) s += red[(k * 3 + set) * 64 + c];
            modv[((size_t)l * 3 + set) * 6144 + col] = s + p.in[I_MODB][l * 6144 + col];
        }
        __syncthreads();
    }
}
__device__ __forceinline__ void rope_tables(const Params& p, int gtid, int ngt) {
    float* ra = (float*)(p.ws + WS_ROPEA); float* rr = (float*)(p.ws + WS_ROPER);
    for (int i = gtid; i < 128 * 80; i += ngt) {
        const int pos = i / 80, jj = i % 80;
        const bool isA = jj < 16; const int j = isA ? jj : jj - 16; const float quarter = isA ? 16.f : 64.f;
        const float freq = exp2f(-(float)j / quarter * 13.287712379549449f);
        float s, c; sincos_cw((float)pos * freq, s, c);
        float* dst = isA ? ra + (pos * 16 + j) * 2 : rr + (pos * 64 + j) * 2;
        dst[0] = c; dst[1] = s;
    }
}

__device__ __forceinline__ void rows_phase(const Params& p, int mode, int nrows, const float* gA, int lm_gate, int gate_idx, bool make_u, const float* gB, int lm_u, int shift_idx, int gw, int ngw, int lane, bool final_out = false) {
    const float* modv = (const float*)(p.ws + WS_MOD);
    bf16* UY = (bf16*)(p.ws + WS_UY);
    bf16* HB = (bf16*)(p.ws + WS_HB);
    for (int row0 = gw * 2; row0 < nrows; row0 += ngw * 2) {
        f32x4 hx[2][4]; u32x2 yw[2][4], hw[2][4];
#pragma unroll
        for (int rr = 0; rr < 2; ++rr) {
            const int row = row0 + rr;
            if (mode == 0) {
                const float* src = row < ML ? p.in[I_X] + (size_t)row * D : p.in[I_CTX] + (size_t)(row - ML) * D;
#pragma unroll
                for (int k = 0; k < 4; ++k) hx[rr][k] = *(const f32x4*)(src + k * 256 + lane * 4);
            } else {
#pragma unroll
                for (int k = 0; k < 4; ++k) { yw[rr][k] = *(const u32x2*)(UY + (size_t)row * D + k * 256 + lane * 4); hw[rr][k] = *(const u32x2*)(HB + (size_t)row * D + k * 256 + lane * 4); }
            }
        }
#pragma unroll
        for (int rr = 0; rr < 2; ++rr) {
            const int row = row0 + rr;
            const int set = row < 8192 ? 0 : (row < ML ? 1 : 2);
            bf16* hrow = HB + (size_t)row * D;
            f32x4 h[4];
            if (mode == 0) {
#pragma unroll
                for (int k = 0; k < 4; ++k) h[k] = hx[rr][k];
            } else {
                f32x4 y[4]; float ss = 0.f;
#pragma unroll
                for (int k = 0; k < 4; ++k) {
                    const u32x2 w = yw[rr][k];
                    y[k] = (f32x4){bflo(w.x), bfhi(w.x), bflo(w.y), bfhi(w.y)};
                    ss += y[k][0] * y[k][0] + y[k][1] * y[k][1] + y[k][2] * y[k][2] + y[k][3] * y[k][3];
                }
                const float rs = rsqrtf(wave_sum(ss) * (1.f / D) + EPS);
                const float* gate = modv + ((size_t)lm_gate * 3 + set) * 6144 + gate_idx * 1024;
#pragma unroll
                for (int k = 0; k < 4; ++k) {
                    const int c0 = k * 256 + lane * 4;
                    const u32x2 hq = hw[rr][k]; const f32x4 hv = {bflo(hq.x), bfhi(hq.x), bflo(hq.y), bfhi(hq.y)};
                    const f32x4 gv = *(const f32x4*)(gA + c0), gt = *(const f32x4*)(gate + c0);
                    h[k] = hv + gt * (y[k] * rs * gv);
                }
            }
            if (final_out) {
#pragma unroll
                for (int k = 0; k < 4; ++k) *(f32x4*)(p.out + (size_t)row * D + k * 256 + lane * 4) = h[k];
            } else {
#pragma unroll
                for (int k = 0; k < 4; ++k) { u32x2 w; w.x = pk2(h[k][0], h[k][1]); w.y = pk2(h[k][2], h[k][3]); *(u32x2*)(hrow + k * 256 + lane * 4) = w; }
            }
            if (make_u) {
                float ss = 0.f;
#pragma unroll
                for (int k = 0; k < 4; ++k) ss += h[k][0] * h[k][0] + h[k][1] * h[k][1] + h[k][2] * h[k][2] + h[k][3] * h[k][3];
                const float rs = rsqrtf(wave_sum(ss) * (1.f / D) + EPS);
                const float* shift = modv + ((size_t)lm_u * 3 + set) * 6144 + shift_idx * 1024;
                const float* scale = shift + 1024;
#pragma unroll
                for (int k = 0; k < 4; ++k) {
                    const int c0 = k * 256 + lane * 4;
                    const f32x4 gv = *(const f32x4*)(gB + c0), sh = *(const f32x4*)(shift + c0), sc = *(const f32x4*)(scale + c0);
                    const f32x4 v = (h[k] * rs * gv) * (1.f + sc) + sh;
                    u32x2 w; w.x = pk2(v[0], v[1]); w.y = pk2(v[2], v[3]);
                    *(u32x2*)(UY + (size_t)row * D + c0) = w;
                }
            }
        }
    }
}

template <int K> __device__ __forceinline__ void ctx_gemm(ldsp lds, const bf16* __restrict__ A, const bf16* __restrict__ Bt, bf16* __restrict__ Y) {
    int tid = threadIdx.x; asm volatile("" : "+v"(tid));
    const int lane = tid & 63, wid = __builtin_amdgcn_readfirstlane(tid >> 6), r = lane & 31, hh = lane >> 5;
    constexpr int KQ = K / 8, NS = KQ / 16, NB = (NS % 11 == 0) ? 11 : 8;
    static_assert(NS % NB == 0, "ctx_gemm K split");
    LAS float* red = (LAS float*)lds;
    for (int tile = blockIdx.x; tile < 512; tile += gridDim.x) {
        const int tm = tile >> 5, tn = tile & 31;
        const bf16* ap = A + (size_t)(ML + tm * 32 + r) * K + wid * KQ + hh * 8;
        const bf16* bp = Bt + (size_t)(tn * 32 + r) * K + wid * KQ + hh * 8;
        f32x16 acc;
#pragma unroll
        for (int e = 0; e < 16; ++e) acc[e] = 0.f;
#pragma unroll 1
        for (int s0 = 0; s0 < NS; s0 += NB) {
            bf16x8 af[NB], bfr[NB];
#pragma unroll
            for (int s = 0; s < NB; ++s) { af[s] = *(const bf16x8*)(ap + (s0 + s) * 16); bfr[s] = *(const bf16x8*)(bp + (s0 + s) * 16); }
#pragma unroll
            for (int s = 0; s < NB; ++s) acc = mfma32(af[s], bfr[s], acc);
        }
        __syncthreads();
        LAS float* rp = red + (wid * 32) * 33 + r;
#pragma unroll
        for (int e = 0; e < 16; ++e) rp[crow(e, hh) * 33] = acc[e];
        __syncthreads();
        if (tid < 256) {
            const int row = tid >> 3, c4 = (tid & 7) * 4;
            const LAS float* sp = red + row * 33 + c4;
            float v[4];
#pragma unroll
            for (int e = 0; e < 4; ++e) { float a = 0.f;
#pragma unroll
                for (int k = 0; k < 8; ++k) a += sp[k * 32 * 33 + e];
                v[e] = a; }
            u32x2 w; w.x = pk2(v[0], v[1]); w.y = pk2(v[2], v[3]);
            *(u32x2*)(Y + (size_t)(ML + tm * 32 + row) * D + tn * 32 + c4) = w;
        }
    }
}

constexpr int AT_KST = 272, AT_VST = 320;
constexpr int AT_KBUF = 64 * AT_KST, AT_VBUF = 64 * AT_VST, AT_STAGE = AT_KBUF + AT_VBUF;
static_assert(3 * AT_STAGE <= LDS_BYTES - 64 && 4 * 64 * 64 * 4 <= 3 * AT_STAGE, "attention LDS");

__device__ __forceinline__ void attn_phase(ldsp lds, const bf16* __restrict__ P, bf16* __restrict__ O, const float* lamv, const float* subln, float lam_init, bool with_ctx) {
    int tid = threadIdx.x; asm volatile("" : "+v"(tid));
    const int lane = tid & 63, wid = __builtin_amdgcn_readfirstlane(tid >> 6), r = lane & 31, hh = lane >> 5;
    const int q4 = (lane & 15) >> 2, p4 = lane & 3, blk = (lane >> 4) & 1;
    const int qb = wid & 3, sh = wid >> 2;
    float lam;
    { const float a = lamv[lane] * lamv[64 + lane], b = lamv[128 + lane] * lamv[192 + lane]; lam = expf(wave_sum(a)) - expf(wave_sum(b)) + lam_init; }
    const int G = gridDim.x, bid = blockIdx.x;
    const int vb = (G % 8 == 0) ? (bid % 8) * (G / 8) + bid / 8 : bid;
    const int NU = 1024 + (with_ctx ? 32 : 0);
    const int srow = tid >> 4, sch = tid & 15;
    for (int u = vb; u < NU; u += G) {
        int b, h, qrow0, NT;
        if (u < 1024) { b = u >> 9; h = (u >> 6) & 7; qrow0 = b * SEQ + (u & 63) * 128; NT = 132; }
        else { const int v = u - 1024; b = v >> 4; h = (v >> 1) & 7; qrow0 = ML + b * CTX + (v & 1) * 128; NT = 4; }
        bf16x8 qf[4];
        {
            const bf16* qp = P + (size_t)(qrow0 + qb * 32 + r) * 3072 + h * 128 + sh * 64 + hh * 8;
#pragma unroll
            for (int d0 = 0; d0 < 4; ++d0) qf[d0] = *(const bf16x8*)(qp + d0 * 16);
        }
        f32x16 Oa[4];
#pragma unroll
        for (int d0 = 0; d0 < 4; ++d0)
#pragma unroll
            for (int e = 0; e < 16; ++e) Oa[d0][e] = 0.f;
        float mrun = 0.f, lrun = 0.f, mx;
        f32x16 zero16;
#pragma unroll
        for (int e = 0; e < 16; ++e) zero16[e] = 0.f;
        u32x4 sA[4], sB[4];
        const bf16* gK = P + (size_t)srow * 3072 + 1024 + h * 128 + sch * 8;
        const int ctx0 = ML + b * CTX, lat0 = b * SEQ - 256;
#define AT_TROW(t) ((t) < 4 ? ctx0 + (t) * 64 : lat0 + (t) * 64)
#define AT_LOAD(sreg, t) do { const bf16* g_ = gK + (size_t)AT_TROW(t) * 3072; sreg[0] = *(const u32x4*)g_; sreg[1] = *(const u32x4*)(g_ + 32 * 3072); sreg[2] = *(const u32x4*)(g_ + 1024); sreg[3] = *(const u32x4*)(g_ + 32 * 3072 + 1024); } while (0)
#define AT_STORE(sreg, so) do { ldsp kb_ = lds + (so) + srow * AT_KST + sch * 16; *(LAS u32x4*)kb_ = sreg[0]; *(LAS u32x4*)(kb_ + 32 * AT_KST) = sreg[1]; \
            ldsp vb_ = lds + (so) + AT_KBUF + srow * AT_VST + sch * 16; *(LAS u32x4*)vb_ = sreg[2]; *(LAS u32x4*)(vb_ + 32 * AT_VST) = sreg[3]; } while (0)
#define AT_QK(N0, N1, so, INIT) do { cldsp kb_ = lds + (so) + r * AT_KST + (sh * 64 + hh * 8) * 2; \
            _Pragma("unroll") for (int d0 = 0; d0 < 4; ++d0) { \
                const bf16x8 ka_ = *(const LAS bf16x8*)(kb_ + d0 * 32), kc_ = *(const LAS bf16x8*)(kb_ + 32 * AT_KST + d0 * 32); \
                if (d0 == 0) { N0 = mfma32(ka_, qf[0], zero16); N1 = mfma32(kc_, qf[0], zero16); } \
                else { N0 = mfma32(ka_, qf[d0], N0); N1 = mfma32(kc_, qf[d0], N1); } } } while (0)
#define AT_MAX(N0, N1) do { float ma_, mb_; \
            asm volatile("s_nop 15\n\ts_nop 7\n\tv_max3_f32 %0, %1, %2, %3" : "=v"(ma_) : "v"(N0[0]), "v"(N0[1]), "v"(N1[0])); \
            asm volatile("v_max3_f32 %0, %1, %2, %3" : "=v"(mb_) : "v"(N0[2]), "v"(N0[3]), "v"(N1[1])); \
            asm volatile("v_max3_f32 %0, %1, %2, %3" : "=v"(ma_) : "v"(ma_), "v"(N1[2]), "v"(N1[3])); \
            _Pragma("unroll") for (int e = 4; e < 16; e += 4) { \
                asm volatile("v_max3_f32 %0, %1, %2, %3" : "=v"(ma_) : "v"(ma_), "v"(N0[e]), "v"(N0[e + 1])); \
                asm volatile("v_max3_f32 %0, %1, %2, %3" : "=v"(mb_) : "v"(mb_), "v"(N0[e + 2]), "v"(N0[e + 3])); \
                asm volatile("v_max3_f32 %0, %1, %2, %3" : "=v"(ma_) : "v"(ma_), "v"(N1[e]), "v"(N1[e + 1])); \
                asm volatile("v_max3_f32 %0, %1, %2, %3" : "=v"(mb_) : "v"(mb_), "v"(N1[e + 2]), "v"(N1[e + 3])); } \
            mx = __builtin_fmaxf(ma_, mb_); mx = __builtin_fmaxf(mx, __shfl_xor(mx, 32)); } while (0)
#define AT_PV(s, PF, vbase) do { _Pragma("unroll") for (int d0 = 0; d0 < 4; ++d0) { \
                const s16x4 lo_ = tr4((vbase) + (16 * (s)) * AT_VST + d0 * 64), hi_ = tr4((vbase) + (16 * (s) + 8) * AT_VST + d0 * 64); \
                Oa[d0] = mfma32(cat8(lo_, hi_), PF, Oa[d0]); } } while (0)
#define AT_MIX(npre, nper, niter, nv) do { __builtin_amdgcn_sched_group_barrier(0x100, (npre), 0); \
            _Pragma("unroll") for (int i_ = 0; i_ < 8; ++i_) { __builtin_amdgcn_sched_group_barrier(0x008, 1, 0); \
                if (i_ < (niter)) __builtin_amdgcn_sched_group_barrier(0x100, (nper), 0); \
                __builtin_amdgcn_sched_group_barrier(0x002, (nv), 0); } } while (0)
#define AT_SOFT(P0, P1, t) do { \
            AT_MAX(P0, P1); \
            if (__builtin_amdgcn_ballot_w64(!(__builtin_fabsf(mx) <= 60.f) || mrun != 0.f) != 0ull) { \
                const float mnew_ = ((t) == 0) ? mx : fmaxf(mrun, mx), alpha_ = ((t) == 0) ? 1.f : fexp2(mrun - mnew_); mrun = mnew_; \
                _Pragma("unroll") for (int e = 0; e < 16; ++e) { P0[e] -= mnew_; P1[e] -= mnew_; } \
                lrun *= alpha_; \
                if (__builtin_amdgcn_ballot_w64(alpha_ != 1.f) != 0ull) { \
                    _Pragma("unroll") for (int d0 = 0; d0 < 4; ++d0) _Pragma("unroll") for (int e = 0; e < 16; ++e) Oa[d0][e] *= alpha_; } \
            } \
            float sum_ = 0.f; \
            _Pragma("unroll") for (int e = 0; e < 16; ++e) { P0[e] = fexp2(P0[e]); sum_ += P0[e]; } \
            pf0 = pack8<0>(P0); pf1 = pack8<8>(P0); \
            _Pragma("unroll") for (int e = 0; e < 16; ++e) { P1[e] = fexp2(P1[e]); sum_ += P1[e]; } \
            pf2 = pack8<0>(P1); pf3 = pack8<8>(P1); \
            lrun += sum_; } while (0)
#define AT_PVALL(so) do { cldsp vbase_ = lds + (so) + AT_KBUF + (4 * hh + q4) * AT_VST + (16 * blk + 4 * p4) * 2; \
            AT_PV(0, pf0, vbase_); AT_PV(1, pf1, vbase_); AT_PV(2, pf2, vbase_); AT_PV(3, pf3, vbase_); } while (0)
#define AT_HEAD(S, t) do { __builtin_amdgcn_sched_barrier(0); AT_STORE(S, sW); { const int tn3_ = ((t) + 3 < NT) ? (t) + 3 : NT - 1; AT_LOAD(S, tn3_); } } while (0)
#define AT_TAIL() do { { const int t_ = sVp; sVp = sV; sV = sW; sW = t_; } __syncthreads(); } while (0)
        AT_LOAD(sA, 0); AT_STORE(sA, 0);
        AT_LOAD(sB, 1); AT_LOAD(sA, 2);
        __syncthreads();
        int sVp = 2 * AT_STAGE, sV = 0, sW = AT_STAGE;
        f32x16 c0, c1;
        bf16x8 pf0 = {0, 0, 0, 0, 0, 0, 0, 0}, pf1 = pf0, pf2 = pf0, pf3 = pf0;
#define AT_STEP_A(S, t) do { AT_HEAD(S, t); AT_QK(c0, c1, sV, 0.f); AT_SOFT(c0, c1, t); __builtin_amdgcn_sched_barrier(0); AT_PVALL(sV); AT_TAIL(); } while (0)
#define AT_STEP_B(S, t) do { AT_HEAD(S, t); AT_QK(c0, c1, sV, 0.f); { const int sp_ = ((t) > 0) ? sVp : sV; AT_PVALL(sp_); } __builtin_amdgcn_sched_barrier(0); AT_SOFT(c0, c1, t); AT_TAIL(); } while (0)
        if (sh == 0) {
            for (int t = 0; t < NT; t += 2) { AT_STEP_A(sB, t); AT_STEP_A(sA, t + 1); }
        } else {
            for (int t = 0; t < NT; t += 2) { AT_STEP_B(sB, t); AT_STEP_B(sA, t + 1); }
            AT_PVALL(sVp);
        }
        __syncthreads();
        const float ltot = lrun + __shfl_xor(lrun, 32);
        LAS float* X = (LAS float*)lds + (size_t)(qb * 64) * 64 + lane;
        if (sh == 1) {
            const float sc = lam / ltot;
#pragma unroll
            for (int d0 = 0; d0 < 4; ++d0)
#pragma unroll
                for (int e = 0; e < 16; ++e) X[(d0 * 16 + e) * 64] = Oa[d0][e] * sc;
        }
        __syncthreads();
        if (sh == 0) {
            const float inv0 = 1.f / ltot;
            float ss = 0.f;
#pragma unroll
            for (int d0 = 0; d0 < 4; ++d0)
#pragma unroll
                for (int e = 0; e < 16; ++e) { const float v = Oa[d0][e] * inv0 - X[(d0 * 16 + e) * 64]; Oa[d0][e] = v; ss += v * v; }
            ss += __shfl_xor(ss, 32);
            const float rs = rsqrtf(ss * (1.f / 128.f) + EPS) * (1.f - lam_init);
            bf16* op = O + (size_t)(qrow0 + qb * 32 + r) * D + h * 128;
#pragma unroll
            for (int d0 = 0; d0 < 4; ++d0)
#pragma unroll
                for (int g4 = 0; g4 < 4; ++g4) {
                    const int dv = 32 * d0 + 8 * g4 + 4 * hh;
                    const f32x4 gs = *(const f32x4*)(subln + dv);
                    u32x2 w; w.x = pk2(Oa[d0][4 * g4 + 0] * rs * gs[0], Oa[d0][4 * g4 + 1] * rs * gs[1]);
                    w.y = pk2(Oa[d0][4 * g4 + 2] * rs * gs[2], Oa[d0][4 * g4 + 3] * rs * gs[3]);
                    *(u32x2*)(op + dv) = w;
                }
        }
        __syncthreads();
    }
#undef AT_TROW
#undef AT_LOAD
#undef AT_STORE
#undef AT_QK
#undef AT_PV
#undef AT_MAX
#undef AT_MIX
#undef AT_HEAD
#undef AT_STEP_A
#undef AT_STEP_B
#undef AT_TAIL
#undef AT_SOFT
#undef AT_PVALL
}

constexpr int RB_KST = 528;
constexpr int RB_VST = 80;
constexpr int RB_RST = 528;
constexpr int RB_K = 0, RB_V = 64 * RB_KST, RB_R = RB_V + 64 * RB_VST, RB_BUF = RB_R + 32 * RB_RST;
static_assert(2 * RB_BUF + 8 * 1024 <= LDS_BYTES - 64, "RB LDS");

__device__ __forceinline__ void retn_rb(ldsp lds, const bf16* __restrict__ P, bf16* __restrict__ OF, bf16* __restrict__ OB, const float* decay_logit) {
    int tid = threadIdx.x; asm volatile("" : "+v"(tid));
    const int lane = tid & 63, wid = __builtin_amdgcn_readfirstlane(tid >> 6), r = lane & 31, hh = lane >> 5;
    const int q4 = (lane & 15) >> 2, p4 = lane & 3, blk = (lane >> 4) & 1;
    const int n16 = lane & 15, quad = lane >> 4, tq = wid & 3, dq = wid >> 2;
    const int G_ = gridDim.x, bid_ = blockIdx.x, vb_ = (G_ % 8 == 0) ? (bid_ % 8) * (G_ / 8) + bid_ / 8 : bid_;
    for (int it = vb_; it < 256; it += G_) {
        const int b = it >> 7, h = (it >> 5) & 3, dir = (it >> 4) & 1, sl = it & 15;
        const float dl = decay_logit[dir * 4 + h];
        const float log2g = -log2f(1.f + expf(-dl));
        const float g64 = exp2f(64.f * log2g);
        bf16* Oout = (dir ? OB : OF) + h * 512 + sl * 32 + dq * 16 + n16;
        f32x16 R;
#pragma unroll
        for (int e = 0; e < 16; ++e) R[e] = 0.f;
        u32x4 k0[4], k1[4], v0, v1;
        bf16x8 qa[8], qb[8], qc[8];
        float qd[4];
#pragma unroll
        for (int j = 0; j < 4; ++j) qd[j] = exp2f((float)(tq * 16 + quad * 4 + j + 1) * log2g);
        const float kd = exp2f((float)(63 - (tid >> 2)) * log2g);
#define RB_ROWBASE(c) (((c) < 4) ? ML + b * CTX + (dir ? 3 - (c) : (c)) * 64 : b * SEQ + (dir ? 127 - ((c) - 4) : ((c) - 4)) * 64)
#define RB_IOFF(i) (dir ? 63 - (i) : (i))
        const long kstep_ = dir ? -16L * 4096 : 16L * 4096;
        const bf16* kp_ = P + (size_t)RB_IOFF(tid >> 5) * 4096 + 1024 + h * 256 + (tid & 31) * 8;
        const bf16* vp_ = P + (size_t)RB_IOFF((tid >> 2) & 63) * 4096 + 2048 + h * 512 + sl * 32 + (tid & 3) * 8;
        const bf16* qp_ = P + (size_t)RB_IOFF(tq * 16 + n16) * 4096 + h * 256 + quad * 8;
        bf16* op_ = (dir ? OB : OF) + h * 512 + sl * 32 + dq * 16 + (size_t)RB_IOFF(tq * 16 + ((lane & 31) >> 1)) * 2048 + (lane & 1) * 8;
        LAS bf16* wt_ = (LAS bf16*)(lds + 2 * RB_BUF + wid * 1024);
#define RB_LOADKV(kreg, vreg, c) do { const size_t ro_ = (size_t)RB_ROWBASE(c) * 4096; \
            _Pragma("unroll") for (int k_ = 0; k_ < 4; ++k_) kreg[k_] = *(const u32x4*)(kp_ + ro_ + k_ * kstep_); \
            if (tid < 256) vreg = *(const u32x4*)(vp_ + ro_); } while (0)
#define RB_LOADQ(QF, c) do { const bf16* q_ = qp_ + (size_t)RB_ROWBASE(c) * 4096; \
            _Pragma("unroll") for (int ks = 0; ks < 8; ++ks) QF[ks] = *(const bf16x8*)(q_ + ks * 32); } while (0)
#define RB_STOREKV(kreg, vreg, bo) do { _Pragma("unroll") for (int k_ = 0; k_ < 4; ++k_) { const int cc_ = tid + 512 * k_, i_ = cc_ >> 5, ch_ = cc_ & 31; \
                *(LAS u32x4*)(lds + (bo) + RB_K + i_ * RB_KST + ch_ * 16) = kreg[k_]; } \
            if (tid < 256) { const int i_ = tid >> 2, ch_ = tid & 3; u32x4 w_; \
                w_.x = pk2(bflo(vreg.x) * kd, bfhi(vreg.x) * kd); w_.y = pk2(bflo(vreg.y) * kd, bfhi(vreg.y) * kd); w_.z = pk2(bflo(vreg.z) * kd, bfhi(vreg.z) * kd); w_.w = pk2(bflo(vreg.w) * kd, bfhi(vreg.w) * kd); \
                *(LAS u32x4*)(lds + (bo) + RB_V + i_ * RB_VST + ch_ * 16) = w_; } } while (0)
#define RB_STORER(bo) do { _Pragma("unroll") for (int g4 = 0; g4 < 4; ++g4) { u32x2 w_; w_.x = pk2(R[4 * g4], R[4 * g4 + 1]); w_.y = pk2(R[4 * g4 + 2], R[4 * g4 + 3]); \
                *(LAS u32x2*)(lds + (bo) + RB_R + r * RB_RST + (32 * wid + 8 * g4 + 4 * hh) * 2) = w_; } } while (0)
#define RB_STEP(QF, QL, KS, VS, c, cur, nxt) do { \
            RB_STOREKV(KS, VS, nxt); \
            { const int c3_ = ((c) + 3 < 132) ? (c) + 3 : 131; RB_LOADKV(KS, VS, c3_); } \
            { const int c2_ = ((c) + 2 < 132) ? (c) + 2 : 131; RB_LOADQ(QL, c2_); } \
            { f32x4 acc_ = {0.f, 0.f, 0.f, 0.f}; \
              cldsp rt_ = lds + (cur) + RB_R + (dq * 16 + n16) * RB_RST + quad * 16; \
              _Pragma("unroll") for (int ks = 0; ks < 8; ++ks) acc_ = mfma16(QF[ks], *(const LAS bf16x8*)(rt_ + ks * 64), acc_); \
              _Pragma("unroll") for (int j = 0; j < 4; ++j) wt_[(4 * quad + j) * 24 + n16] = (bf16)(pk2(acc_[j] * qd[j], 0.f) & 0xffffu); \
              const u32x4 ov_ = *(const LAS u32x4*)(wt_ + ((lane & 31) >> 1) * 24 + (lane & 1) * 8); \
              if (lane < 32) *(u32x4*)(op_ + (size_t)RB_ROWBASE(c) * 2048) = ov_; } \
            { _Pragma("unroll") for (int e = 0; e < 16; ++e) R[e] *= g64; \
              cldsp Kb_ = lds + (cur) + RB_K + (8 * hh + q4) * RB_KST + (32 * wid + 16 * blk + 4 * p4) * 2; \
              cldsp Vb_ = lds + (cur) + RB_V + (8 * hh + q4) * RB_VST + (16 * blk + 4 * p4) * 2; \
              _Pragma("unroll") for (int ks = 0; ks < 4; ++ks) { \
                  const s16x4 alo_ = tr4(Kb_ + (16 * ks) * RB_KST), ahi_ = tr4(Kb_ + (16 * ks + 4) * RB_KST); \
                  const s16x4 blo_ = tr4(Vb_ + (16 * ks) * RB_VST), bhi_ = tr4(Vb_ + (16 * ks + 4) * RB_VST); \
                  R = mfma32(cat8(alo_, ahi_), cat8(blo_, bhi_), R); } } \
            RB_STORER(nxt); \
            __syncthreads(); __builtin_amdgcn_sched_barrier(0); } while (0)
        RB_LOADKV(k0, v0, 0); RB_STOREKV(k0, v0, 0); RB_STORER(0);
        RB_LOADKV(k1, v1, 1); RB_LOADKV(k0, v0, 2); RB_LOADQ(qa, 0); RB_LOADQ(qb, 1);
        __syncthreads();
        for (int c = 0; c < 132; c += 6) {
            RB_STEP(qa, qc, k1, v1, c, 0, RB_BUF);
            RB_STEP(qb, qa, k0, v0, c + 1, RB_BUF, 0);
            RB_STEP(qc, qb, k1, v1, c + 2, 0, RB_BUF);
            RB_STEP(qa, qc, k0, v0, c + 3, RB_BUF, 0);
            RB_STEP(qb, qa, k1, v1, c + 4, 0, RB_BUF);
            RB_STEP(qc, qb, k0, v0, c + 5, RB_BUF, 0);
        }
    }
#undef RB_ROWBASE
#undef RB_IOFF
#undef RB_LOADKV
#undef RB_LOADQ
#undef RB_STOREKV
#undef RB_STORER
#undef RB_STEP
}

constexpr int RA_QST = 528, RA_VST = 1040, RA_SST = 144;
constexpr int RA_Q = 0, RA_K = 64 * RA_QST, RA_V = 2 * 64 * RA_QST, RA_S = RA_V + 64 * RA_VST, RA_ST = RA_S + 64 * RA_SST;
static_assert(RA_ST + 64 * 4 * 4 <= LDS_BYTES, "RA LDS");

__device__ __forceinline__ void retn_ra(ldsp lds, const bf16* __restrict__ P, bf16* __restrict__ OF, const bf16* __restrict__ OB, const float* decay_logit) {
    int tid = threadIdx.x; asm volatile("" : "+v"(tid));
    const int lane = tid & 63, wid = __builtin_amdgcn_readfirstlane(tid >> 6), r = lane & 31, hh = lane >> 5;
    const int q4 = (lane & 15) >> 2, p4 = lane & 3, blk = (lane >> 4) & 1;
    for (int u = blockIdx.x; u < 2 * 4 * 132; u += gridDim.x) {
        const int b = u / 528, h = (u / 132) & 3, cc = u % 132;
        const int rowbase = cc < 4 ? ML + b * CTX + cc * 64 : b * SEQ + (cc - 4) * 64;
        const float lgf = -log2f(1.f + expf(-decay_logit[h])), lgb = -log2f(1.f + expf(-decay_logit[4 + h]));
#pragma unroll
        for (int k = 0; k < 4; ++k) {
            const int c = tid + 512 * k, i = c >> 5, ch = c & 31;
            const bf16* g = P + (size_t)(rowbase + i) * 4096 + h * 256 + ch * 8;
            *(LAS u32x4*)(lds + RA_Q + i * RA_QST + ch * 16) = *(const u32x4*)g;
            *(LAS u32x4*)(lds + RA_K + i * RA_QST + ch * 16) = *(const u32x4*)(g + 1024);
        }
#pragma unroll
        for (int k = 0; k < 8; ++k) {
            const int c = tid + 512 * k, i = c >> 6, ch = c & 63;
            *(LAS u32x4*)(lds + RA_V + i * RA_VST + ch * 16) = *(const u32x4*)(P + (size_t)(rowbase + i) * 4096 + 2048 + h * 512 + ch * 8);
        }
        __syncthreads();
        if (wid < 4) {
            const int kj = wid >> 1, qi = wid & 1;
            f32x16 s;
#pragma unroll
            for (int e = 0; e < 16; ++e) s[e] = 0.f;
#pragma unroll
            for (int ks = 0; ks < 16; ++ks) {
                const bf16x8 a = *(const LAS bf16x8*)(lds + RA_K + (kj * 32 + r) * RA_QST + (ks * 16 + hh * 8) * 2);
                const bf16x8 bb = *(const LAS bf16x8*)(lds + RA_Q + (qi * 32 + r) * RA_QST + (ks * 16 + hh * 8) * 2);
                s = mfma32(a, bb, s);
            }
            const int q = qi * 32 + r;
#pragma unroll
            for (int g4 = 0; g4 < 4; ++g4) {
                float v[4];
#pragma unroll
                for (int e = 0; e < 4; ++e) {
                    const int k = kj * 32 + 8 * g4 + 4 * hh + e, df = q - k;
                    float dcy = 0.f;
                    if (df >= 0) dcy += exp2f((float)df * lgf);
                    if (df <= 0) dcy += exp2f((float)(-df) * lgb);
                    v[e] = s[4 * g4 + e] * dcy;
                }
                u32x2 w; w.x = pk2(v[0], v[1]); w.y = pk2(v[2], v[3]);
                *(LAS u32x2*)(lds + RA_S + q * RA_SST + (kj * 32 + 8 * g4 + 4 * hh) * 2) = w;
            }
        }
        __syncthreads();
        u32x4 fa[4], fb[4];
#define RA_TLOAD(k0) do { _Pragma("unroll") for (int k = 0; k < 4; ++k) { const int c = tid + 512 * ((k0) + k), i = c >> 6, ch = c & 63; \
                const size_t o_ = (size_t)(rowbase + i) * 2048 + h * 512 + ch * 8; fa[k] = *(const u32x4*)(OF + o_); fb[k] = *(const u32x4*)(OB + o_); } } while (0)
#define RA_ADD2(x, y) pk2(bflo(x) + bflo(y), bfhi(x) + bfhi(y))
#define RA_TSTORE(k0) do { _Pragma("unroll") for (int k = 0; k < 4; ++k) { const int c = tid + 512 * ((k0) + k), i = c >> 6, ch = c & 63; u32x4 w_; \
                w_.x = RA_ADD2(fa[k].x, fb[k].x); w_.y = RA_ADD2(fa[k].y, fb[k].y); w_.z = RA_ADD2(fa[k].z, fb[k].z); w_.w = RA_ADD2(fa[k].w, fb[k].w); \
                *(LAS u32x4*)(lds + i * RA_VST + ch * 16) = w_; } } while (0)
        RA_TLOAD(0);
        const int qi = wid & 1, dvr = (wid >> 1) * 128;
        f32x16 acc[4];
#pragma unroll
        for (int db = 0; db < 4; ++db)
#pragma unroll
            for (int e = 0; e < 16; ++e) acc[db][e] = 0.f;
        {
            cldsp Vb = lds + RA_V + (8 * hh + q4) * RA_VST + (dvr + 16 * blk + 4 * p4) * 2;
#pragma unroll
            for (int ks = 0; ks < 4; ++ks) {
                const bf16x8 a = *(const LAS bf16x8*)(lds + RA_S + (qi * 32 + r) * RA_SST + (ks * 16 + hh * 8) * 2);
#pragma unroll
                for (int db = 0; db < 4; ++db) {
                    const s16x4 lo = tr4(Vb + (16 * ks) * RA_VST + db * 64), hi = tr4(Vb + (16 * ks + 4) * RA_VST + db * 64);
                    acc[db] = mfma32(a, cat8(lo, hi), acc[db]);
                }
            }
        }
        RA_TSTORE(0); RA_TLOAD(4); RA_TSTORE(4);
        __syncthreads();
        float ssq[16];
#pragma unroll
        for (int e = 0; e < 16; ++e) {
            const LAS bf16* tp = (const LAS bf16*)(lds + (qi * 32 + crow(e, hh)) * RA_VST) + dvr + r;
            float s2 = 0.f;
#pragma unroll
            for (int db = 0; db < 4; ++db) { const float v = acc[db][e] + __uint_as_float((unsigned)tp[db * 32] << 16); acc[db][e] = v; s2 += v * v; }
            s2 += __shfl_xor(s2, 1); s2 += __shfl_xor(s2, 2); s2 += __shfl_xor(s2, 4); s2 += __shfl_xor(s2, 8); s2 += __shfl_xor(s2, 16);
            ssq[e] = s2;
        }
        LAS float* st = (LAS float*)(lds + RA_ST);
        if (r == 0) {
#pragma unroll
            for (int e = 0; e < 16; ++e) st[(qi * 32 + crow(e, hh)) * 4 + (wid >> 1)] = ssq[e];
        }
        __syncthreads();
#pragma unroll
        for (int e = 0; e < 16; ++e) {
            const int q = qi * 32 + crow(e, hh);
            const f32x4 sv = *(const LAS f32x4*)(st + q * 4);
            const float rs = rsqrtf((sv[0] + sv[1] + sv[2] + sv[3]) * (1.f / 512.f) + EPS);
            LAS bf16* tp = (LAS bf16*)(lds + q * RA_VST) + dvr + r;
#pragma unroll
            for (int db = 0; db < 4; ++db) tp[db * 32] = (bf16)(pk2(acc[db][e] * rs, 0.f) & 0xffffu);
        }
        __syncthreads();
#pragma unroll
        for (int k = 0; k < 8; ++k) { const int c = tid + 512 * k, i = c >> 6, ch = c & 63;
            *(u32x4*)(OF + (size_t)(rowbase + i) * 2048 + h * 512 + ch * 8) = *(const LAS u32x4*)(lds + i * RA_VST + ch * 16); }
#undef RA_TLOAD
#undef RA_ADD2
#undef RA_TSTORE
        __syncthreads();
    }
}

__device__ __forceinline__ int s5_row0(int cidx) { const int b = cidx / 264, cl = cidx % 264; return cl < 8 ? ML + b * CTX + cl * 32 : b * SEQ + (cl - 8) * 32; }

__device__ __forceinline__ void s5_tables(const Params& p, ldsp lds, int tid) {
    LAS float* E = (LAS float*)lds;
    LAS float* BB = E + 33 * 128;
    LAS float* CC = BB + 2048;
    bf16* Mt = (bf16*)(p.ws + WS_P + P_S5_M); bf16* Wt = (bf16*)(p.ws + WS_P + P_S5_W); bf16* Zt = (bf16*)(p.ws + WS_P + P_S5_Z);
    float* A32 = (float*)(p.ws + WS_A32);
    for (int u = blockIdx.x; u < 128; u += gridDim.x) {
        const int g = u >> 1, dir = u & 1, dg = dir * 64 + g;
        const float dt = expf(p.in[I_SLOGDT][dg]);
        for (int i = tid; i < 33 * 64; i += NTHREADS) {
            const int k = i >> 6, pp = i & 63;
            const float lr = p.in[I_SLRE][dg * 64 + pp], li = p.in[I_SLIM][dg * 64 + pp];
            const float mag = expf((float)k * (lr * dt)); float s, c; sincos_cw((float)k * (li * dt), s, c);
            E[i * 2] = mag * c; E[i * 2 + 1] = mag * s;
        }
        for (int i = tid; i < 1024; i += NTHREADS) {
            const int pp = i >> 4;
            const float lr = p.in[I_SLRE][dg * 64 + pp], li = p.in[I_SLIM][dg * 64 + pp];
            const float mag = expf(lr * dt); float s, c; sincos_cw(li * dt, s, c);
            const float nr = mag * c - 1.f, ni = mag * s, den = 1.f / (lr * lr + li * li);
            const float fr = (nr * lr + ni * li) * den, fi = (ni * lr - nr * li) * den;
            const float br = p.in[I_SBRE][(size_t)dg * 1024 + i], bi = p.in[I_SBIM][(size_t)dg * 1024 + i];
            BB[i * 2] = fr * br - fi * bi; BB[i * 2 + 1] = fr * bi + fi * br;
            CC[i * 2] = p.in[I_SCRE][(size_t)dg * 1024 + i]; CC[i * 2 + 1] = p.in[I_SCIM][(size_t)dg * 1024 + i];
        }
        __syncthreads();
        if (tid < 64) { A32[(size_t)(g * 2 + dir) * 128 + tid * 2] = E[(32 * 64 + tid) * 2]; A32[(size_t)(g * 2 + dir) * 128 + tid * 2 + 1] = E[(32 * 64 + tid) * 2 + 1]; }
        const size_t tb = (size_t)(g * 2 + dir);
        for (int i = tid; i < 33 * 256; i += NTHREADS) {
            const int k1 = i >> 8, ci = (i >> 4) & 15, bj = i & 15;
            float acc = 0.f;
            if (k1 > 0) {
                const int k = k1 - 1;
                for (int pp = 0; pp < 64; ++pp) {
                    const float er = E[(k * 64 + pp) * 2], ei = E[(k * 64 + pp) * 2 + 1], cr = CC[(ci * 64 + pp) * 2], cim = CC[(ci * 64 + pp) * 2 + 1];
                    const float xr = cr * er - cim * ei, xi = cr * ei + cim * er;
                    acc += xr * BB[(pp * 16 + bj) * 2] - xi * BB[(pp * 16 + bj) * 2 + 1];
                }
            }
            Mt[tb * (33 * 256) + i] = (bf16)(pk2(acc, 0.f) & 0xffffu);
        }
        for (int i = tid; i < 64 * 512; i += NTHREADS) {
            const int pp = i >> 9, col = i & 511, s = col >> 4, j = col & 15, kk = dir ? s : 31 - s;
            const float er = E[(kk * 64 + pp) * 2], ei = E[(kk * 64 + pp) * 2 + 1], br = BB[(pp * 16 + j) * 2], bi = BB[(pp * 16 + j) * 2 + 1];
            Wt[tb * 65536 + (size_t)(2 * pp) * 512 + col] = (bf16)(pk2(er * br - ei * bi, 0.f) & 0xffffu);
            Wt[tb * 65536 + (size_t)(2 * pp + 1) * 512 + col] = (bf16)(pk2(er * bi + ei * br, 0.f) & 0xffffu);
        }
        for (int i = tid; i < 512 * 64; i += NTHREADS) {
            const int row = i >> 6, pp = i & 63, t = row >> 4, ci = row & 15, e = dir ? 32 - t : t + 1;
            const float er = E[(e * 64 + pp) * 2], ei = E[(e * 64 + pp) * 2 + 1], cr = CC[(ci * 64 + pp) * 2], cim = CC[(ci * 64 + pp) * 2 + 1];
            *(unsigned*)(Zt + tb * 65536 + (size_t)row * 128 + 2 * pp) = pk2(cr * er - cim * ei, -(cr * ei + cim * er));
        }
        __syncthreads();
    }
}

__device__ __forceinline__ void s5_x(const Params& p, int tid) {
    asm volatile("" : "+v"(tid));
    const int lane = tid & 63, wid = __builtin_amdgcn_readfirstlane(tid >> 6), n = lane & 15, quad = lane >> 4;
    const bf16* U = (const bf16*)(p.ws + WS_UY); const bf16* Wt = (const bf16*)(p.ws + WS_P + P_S5_W); float* X = (float*)(p.ws + WS_P + P_S5_X);
    const int G_ = gridDim.x, bid_ = blockIdx.x, vb_ = (G_ % 8 == 0) ? (bid_ % 8) * (G_ / 8) + bid_ / 8 : bid_;
    for (int u = vb_; u < 64 * 33; u += G_) {
        const int ct = u >> 6, g = u & 63, cidx = ct * 16 + n, row0 = s5_row0(cidx);
        bf16x8 uf[16];
#pragma unroll
        for (int ks = 0; ks < 16; ++ks) uf[ks] = *(const bf16x8*)(U + (size_t)(row0 + 2 * ks + (quad >> 1)) * D + g * 16 + 8 * (quad & 1));
#pragma unroll
        for (int dir = 0; dir < 2; ++dir) {
            const bf16* wp = Wt + (size_t)(g * 2 + dir) * 65536 + (size_t)(16 * wid + n) * 512 + 8 * quad;
            f32x4 acc = {0.f, 0.f, 0.f, 0.f};
#pragma unroll
            for (int ks = 0; ks < 16; ++ks) acc = mfma16(*(const bf16x8*)(wp + ks * 32), uf[ks], acc);
            *(f32x4*)(X + ((size_t)(g * 2 + dir) * 528 + cidx) * 128 + 16 * wid + 4 * quad) = acc;
        }
    }
}
__device__ __forceinline__ void s5_scan(const Params& p, int gtid) {
    if (gtid >= 131072) return;
    const int seg = gtid & 7, pp = (gtid >> 3) & 63, dir = (gtid >> 9) & 1, g = (gtid >> 10) & 63, b = gtid >> 16;
    const float* X = (const float*)(p.ws + WS_P + P_S5_X) + (size_t)(g * 2 + dir) * 528 * 128 + 2 * pp;
    bf16* Hs = (bf16*)(p.ws + WS_P + P_S5_H) + (size_t)(g * 2 + dir) * 528 * 128 + 2 * pp;
    const float* A32 = (const float*)(p.ws + WS_A32) + (size_t)(g * 2 + dir) * 128 + 2 * pp;
    const float ar = A32[0], ai = A32[1];
    f32x2 xv[33];
#pragma unroll
    for (int k = 0; k < 33; ++k) {
        const int st = seg * 33 + k;
        const int cl = dir ? (st < 8 ? 7 - st : 263 - (st - 8)) : st;
        xv[k] = *(const f32x2*)(X + (size_t)(b * 264 + cl) * 128);
    }
    float er = 0.f, ei = 0.f, pr = 1.f, pi = 0.f;
#pragma unroll
    for (int k = 0; k < 33; ++k) {
        const float nr = ar * er - ai * ei + xv[k][0], ni = ar * ei + ai * er + xv[k][1]; er = nr; ei = ni;
        const float qr = ar * pr - ai * pi, qi = ar * pi + ai * pr; pr = qr; pi = qi;
    }
    float hr = 0.f, hi = 0.f;
    const int lane = threadIdx.x & 63, lbase = lane & ~7;
#pragma unroll
    for (int j = 0; j < 7; ++j) {
        const float tr_ = __shfl(er, lbase + j), ti_ = __shfl(ei, lbase + j);
        if (j < seg) { const float nr = pr * hr - pi * hi + tr_, ni = pr * hi + pi * hr + ti_; hr = nr; hi = ni; }
    }
#pragma unroll
    for (int k = 0; k < 33; ++k) {
        const int st = seg * 33 + k;
        const int cl = dir ? (st < 8 ? 7 - st : 263 - (st - 8)) : st;
        *(unsigned*)(Hs + (size_t)(b * 264 + cl) * 128) = pk2(hr, hi);
        const float nr = ar * hr - ai * hi + xv[k][0], ni = ar * hi + ai * hr + xv[k][1]; hr = nr; hi = ni;
    }
}
__device__ __forceinline__ void s5_y(const Params& p, ldsp lds, int tid) {
    asm volatile("" : "+v"(tid));
    const int lane = tid & 63, wid = __builtin_amdgcn_readfirstlane(tid >> 6), n = lane & 15, quad = lane >> 4;
    const bf16* U = (const bf16*)(p.ws + WS_UY); const bf16* Mt = (const bf16*)(p.ws + WS_P + P_S5_M); const bf16* Zt = (const bf16*)(p.ws + WS_P + P_S5_Z);
    const bf16* Hs = (const bf16*)(p.ws + WS_P + P_S5_H); bf16* Og = (bf16*)(p.ws + WS_P + P_S5_O);
    const float* dsk = p.in[I_SD];
    for (int i = tid; i < 2 * 1024; i += NTHREADS) *(LAS u32x4*)(lds + (i >> 10) * 32768 + (i & 1023) * 16) = (u32x4){0u, 0u, 0u, 0u};
    const int G_ = gridDim.x, bid_ = blockIdx.x, vb_ = (G_ % 8 == 0) ? (bid_ % 8) * (G_ / 8) + bid_ / 8 : bid_;
    for (int u = vb_; u < 64 * 33; u += G_) {
        const int ct = u >> 6, g = u & 63, cidx = ct * 16 + n, row0 = s5_row0(cidx);
        __syncthreads();
        for (int i = tid; i < 2 * 1024; i += NTHREADS) { const int dir = i >> 10, c = i & 1023;
            *(LAS u32x4*)(lds + dir * 32768 + 16384 + c * 16) = *(const u32x4*)(Mt + (size_t)(g * 2 + dir) * 8448 + 256 + (size_t)c * 8); }
        bf16x8 uf[16], hf[2][4];
#pragma unroll
        for (int ks = 0; ks < 16; ++ks) uf[ks] = *(const bf16x8*)(U + (size_t)(row0 + 2 * ks + (quad >> 1)) * D + g * 16 + 8 * (quad & 1));
#pragma unroll
        for (int dir = 0; dir < 2; ++dir)
#pragma unroll
            for (int kk = 0; kk < 4; ++kk) hf[dir][kk] = *(const bf16x8*)(Hs + ((size_t)(g * 2 + dir) * 528 + cidx) * 128 + kk * 32 + 8 * quad);
        __syncthreads();
        for (int tt = 0; tt < 4; ++tt) {
            const int t = wid * 4 + tt;
            f32x4 acc = {0.f, 0.f, 0.f, 0.f};
            cldsp mf = lds + (t + 32 - (quad >> 1)) * 512 + n * 32 + (quad & 1) * 16;
            cldsp mb = lds + 32768 + (32 - t + (quad >> 1)) * 512 + n * 32 + (quad & 1) * 16;
#pragma unroll
            for (int ks = 0; ks < 16; ++ks) {
                if (2 * ks <= t) acc = mfma16(*(const LAS bf16x8*)(mf - ks * 1024), uf[ks], acc);
                if (2 * ks + 1 >= t) acc = mfma16(*(const LAS bf16x8*)(mb + ks * 1024), uf[ks], acc);
            }
#pragma unroll
            for (int dir = 0; dir < 2; ++dir)
#pragma unroll
                for (int kk = 0; kk < 4; ++kk)
                    acc = mfma16(*(const bf16x8*)(Zt + (size_t)(g * 2 + dir) * 65536 + (size_t)(t * 16 + n) * 128 + kk * 32 + 8 * quad), hf[dir][kk], acc);
            const size_t off = (size_t)(row0 + t) * D + g * 16 + 4 * quad;
            const u32x2 uw = *(const u32x2*)(U + off);
            const f32x4 dv = *(const f32x4*)(dsk + g * 16 + 4 * quad);
            const float y0 = acc[0] + dv[0] * bflo(uw.x), y1 = acc[1] + dv[1] * bfhi(uw.x), y2 = acc[2] + dv[2] * bflo(uw.y), y3 = acc[3] + dv[3] * bfhi(uw.y);
            u32x2 w; w.x = pk2(gelu_tanh(y0), gelu_tanh(y1)); w.y = pk2(gelu_tanh(y2), gelu_tanh(y3));
            *(u32x2*)(Og + off) = w;
        }
    }
}


#define PHASE_BEGIN if (ph >= p.ph_lo && ph < p.ph_hi) {
#define PHASE_END   if (ph + 1 < p.ph_hi) { if (ph == 0) grid.sync(); else xcd_barrier(bar); } } ++ph;
template <int L> __device__ __forceinline__ void layer_body(const Params& p, cg::grid_group& grid, const XcdBarrier& bar, ldsp lds, int& ph) {
    const int tid = threadIdx.x, lane = tid & 63, wave = __builtin_amdgcn_readfirstlane(tid >> 6);
    const int G = gridDim.x;
    const int gw = blockIdx.x * 8 + wave, ngw = G * 8;
    const int gtid = blockIdx.x * NTHREADS + tid;
    bf16* Wb = (bf16*)(p.ws + WS_W);
    bf16* UY = (bf16*)(p.ws + WS_UY);
    unsigned char* Pr = p.ws + WS_P;
    const float* normg = p.in[I_NORMG];
    (void)gtid; (void)lane;

        constexpr int l = L; constexpr int kind = L % 3, j = L / 3;
        constexpr bool last = (L == 3);
        constexpr int Mrows = last ? ML : MT;
        if constexpr (kind == 0) {
            PHASE_BEGIN
                EpiAttnIn E{(bf16*)Pr, (const float*)(p.ws + WS_ROPEA)};
                run_gemm(lds, UY, Wb + W_IN, MT, 3072, D, E);
            PHASE_END
            PHASE_BEGIN
                attn_phase(lds, (const bf16*)Pr, (bf16*)(Pr + P_ATT_O), p.in[I_ALAM] + j * 256, p.in[I_ASUBLN] + j * 128, 0.8f - 0.6f * expf(-0.3f * (float)l), !last);
            PHASE_END
            PHASE_BEGIN
                EpiStore E{UY, D};
                run_gemm(lds, (const bf16*)(Pr + P_ATT_O), Wb + W_OUT, ML, D, D, E);
                if (!last) ctx_gemm<1024>(lds, (const bf16*)(Pr + P_ATT_O), Wb + W_OUT, UY);
            PHASE_END
        } else if constexpr (kind == 1) {
            PHASE_BEGIN
                EpiRetIn E{(bf16*)Pr, (const float*)(p.ws + WS_ROPER)};
                run_gemm(lds, UY, Wb + W_IN, MT, 4096, D, E);
            PHASE_END
            PHASE_BEGIN
                retn_rb(lds, (const bf16*)Pr, (bf16*)(Pr + P_RET_OF), (bf16*)(Pr + P_RET_OB), p.in[I_RDECAY]);
            PHASE_END
            PHASE_BEGIN
                retn_ra(lds, (const bf16*)Pr, (bf16*)(Pr + P_RET_OF), (const bf16*)(Pr + P_RET_OB), p.in[I_RDECAY]);
            PHASE_END
            PHASE_BEGIN
                EpiRetGate E{(bf16*)(Pr + P_RET_OF), 2048};
                run_gemm(lds, UY, Wb + W_G, MT, 2048, D, E);
            PHASE_END
            PHASE_BEGIN
                EpiStore E{UY, D};
                run_gemm(lds, (const bf16*)(Pr + P_RET_OF), Wb + W_OUT, ML, D, 2048, E);
                if (!last) ctx_gemm<2048>(lds, (const bf16*)(Pr + P_RET_OF), Wb + W_OUT, UY);
            PHASE_END
        } else {
            PHASE_BEGIN
                s5_x(p, tid);
            PHASE_END
            PHASE_BEGIN
                s5_scan(p, gtid);
                conv_layer(p, 2, lds, gw, ngw, lane, wave);
            PHASE_END
            PHASE_BEGIN
                s5_y(p, lds, tid);
            PHASE_END
            PHASE_BEGIN
                EpiPair<1> E{UY, D};
                run_gemm(lds, (const bf16*)(Pr + P_S5_O), Wb + W_OUT, Mrows, 2048, D, E);
            PHASE_END
        }
        PHASE_BEGIN
            rows_phase(p, 1, Mrows, normg + l * 4096 + 1 * 1024, l, 2, true, normg + l * 4096 + 2 * 1024, l, 3, gw, ngw, lane);
        PHASE_END
        PHASE_BEGIN
            EpiPair<0> E{(bf16*)Pr, FF};
            run_gemm(lds, UY, Wb + W_GU, Mrows, 2 * FF, D, E);
        PHASE_END
        PHASE_BEGIN
            EpiStore E{UY, D};
            run_gemm(lds, (const bf16*)Pr, Wb + W_DN, ML, D, FF, E);
            if (!last) ctx_gemm<FF>(lds, (const bf16*)Pr, Wb + W_DN, UY);
        PHASE_END
        PHASE_BEGIN
            rows_phase(p, 1, Mrows, normg + l * 4096 + 3 * 1024, l, 5, !last, normg + (last ? 0 : (l + 1) * 4096), last ? 0 : l + 1, 0, gw, ngw, lane, last);
            if (!last) {
                __syncthreads();
                if (l != 1) conv_layer(p, l + 1, lds, gw, ngw, lane, wave);
                if (l == 1) { __syncthreads(); s5_tables(p, lds, tid); }
            }
        PHASE_END
    }
__global__ void __launch_bounds__(NTHREADS, 2) fwd_megakernel(Params p) {
    extern __shared__ __attribute__((aligned(16))) unsigned char lds_raw[];
    cg::grid_group grid = cg::this_grid();
    ldsp lds = (ldsp)lds_raw;
    const int tid = threadIdx.x, lane = tid & 63, wave = __builtin_amdgcn_readfirstlane(tid >> 6);
    const int G = gridDim.x;
    const int gw = blockIdx.x * 8 + wave, ngw = G * 8;
    const int gtid = blockIdx.x * NTHREADS + tid, ngt = G * NTHREADS;
    bf16* Wb = (bf16*)(p.ws + WS_W);
    bf16* UY = (bf16*)(p.ws + WS_UY);
    unsigned char* Pr = p.ws + WS_P;
    const float* normg = p.in[I_NORMG];
    int ph = 0;
    if (tid < 16) ((LAS unsigned*)(lds + LDS_BYTES - 64))[tid] = 0u;
    __syncthreads();
    const XcdBarrier bar = xcd_barrier_post((unsigned*)(p.ws + WS_BAR), (volatile LAS unsigned*)(lds + LDS_BYTES - 64));

    PHASE_BEGIN
        mods_phase(p, lds, tid);
        rope_tables(p, gtid, ngt);
        __syncthreads();
        conv_layer(p, 0, lds, gw, ngw, lane, wave);
    PHASE_END
    PHASE_BEGIN
        rows_phase(p, 0, MT, nullptr, 0, 0, true, normg + 0 * 4096 + 0 * 1024, 0, 0, gw, ngw, lane);
    PHASE_END
    layer_body<0>(p, grid, bar, lds, ph);
    layer_body<1>(p, grid, bar, lds, ph);
    layer_body<2>(p, grid, bar, lds, ph);
    layer_body<3>(p, grid, bar, lds, ph);
#undef PHASE_BEGIN
#undef PHASE_END
}

extern "C" void kernel_launch(void* const* d_in, const int* in_sizes, int n_in, void* d_out, int out_size, void* d_ws, size_t ws_size, hipStream_t stream) {
    static int grid_blocks = 0;
    if (grid_blocks == 0) {
        if (n_in != 26 || out_size != ML * D || ws_size < WS_END) { fprintf(stderr, "kernel_launch: unexpected shapes (n_in %d out %d ws %zu need %zu)\n", n_in, out_size, ws_size, (size_t)WS_END); grid_blocks = -1; return; }
        int dev = 0, cus = 0, per_cu = 0;
        hipGetDevice(&dev);
        hipDeviceGetAttribute(&cus, hipDeviceAttributeMultiprocessorCount, dev);
        hipFuncSetAttribute((const void*)fwd_megakernel, hipFuncAttributeMaxDynamicSharedMemorySize, LDS_BYTES);
        hipOccupancyMaxActiveBlocksPerMultiprocessor(&per_cu, (const void*)fwd_megakernel, NTHREADS, LDS_BYTES);
        if (per_cu < 1) { fprintf(stderr, "kernel_launch: occupancy query returned %d\n", per_cu); per_cu = 1; }
        (void)hipGetLastError();
        grid_blocks = cus;
    }
    if (grid_blocks < 0) return;
    Params p{};
    for (int i = 0; i < 26; ++i) p.in[i] = (const float*)d_in[i];
    p.out = (float*)d_out; p.ws = (unsigned char*)d_ws; p.ph_lo = 0; p.ph_hi = 1000;
    if (hipMemsetAsync((char*)d_ws + WS_BAR, 0, 16384, stream) != hipSuccess) { fprintf(stderr, "kernel_launch: memset failed\n"); return; }
    void* args[] = {&p};
    hipError_t e = hipLaunchCooperativeKernel((const void*)fwd_megakernel, dim3(grid_blocks), dim3(NTHREADS), args, LDS_BYTES, stream);
    if (e != hipSuccess) fprintf(stderr, "cooperative launch failed: %s (grid %d)\n", hipGetErrorString(e), grid_blocks);
}
```

```cpp
#include <hip/hip_runtime.h>
#include <hip/hip_cooperative_groups.h>
#include <cstdint>
#include <cstdio>
namespace cg = cooperative_groups;

typedef unsigned short bf16;
typedef short bf16x8 __attribute__((ext_vector_type(8)));
typedef short s16x4 __attribute__((ext_vector_type(4)));
typedef float f32x2 __attribute__((ext_vector_type(2)));
typedef float f32x4 __attribute__((ext_vector_type(4)));
typedef float f32x16 __attribute__((ext_vector_type(16)));
typedef unsigned u32x2 __attribute__((ext_vector_type(2)));
typedef unsigned u32x4 __attribute__((ext_vector_type(4)));
typedef __bf16 bf16x2_t __attribute__((ext_vector_type(2)));
#define LAS __attribute__((address_space(3)))
typedef LAS unsigned char* ldsp;
typedef const LAS unsigned char* cldsp;

constexpr int D = 1024, SEQ = 8192, CTX = 256, ML = 16384, MT = 16896, FF = 2816;
constexpr float EPS = 1e-6f;
constexpr float LOG2E = 1.4426950408889634f;

constexpr size_t MiB = 1u << 20;
constexpr size_t WS_MOD = 0;
constexpr size_t WS_ROPEA = 512 * 1024;
constexpr size_t WS_ROPER = WS_ROPEA + 64 * 1024;
constexpr size_t WS_A32 = WS_ROPER + 128 * 1024;
constexpr size_t WS_BAR = 800 * 1024;
constexpr size_t WS_HC = 1 * MiB;
constexpr size_t WS_W = 4 * MiB;
constexpr size_t WS_UY = 40 * MiB;
constexpr size_t WS_P = 76 * MiB;
constexpr size_t WS_HB = WS_P + 264 * MiB;
constexpr size_t WS_END = WS_HB + 34 * MiB;
constexpr size_t W_IN = 0, W_G = 4096 * 1024, W_OUT = 6144 * 1024, W_GU = 8192 * 1024 + 1024 * 1024, W_DN = W_GU + 5632 * 1024;
constexpr size_t P_ATT_O = 100 * MiB;
constexpr size_t P_RET_OF = 132 * MiB, P_RET_OB = 198 * MiB;
constexpr size_t P_S5_O = 0;
constexpr size_t P_S5_M = 100 * MiB;
constexpr size_t P_S5_W = 104 * MiB;
constexpr size_t P_S5_Z = 120 * MiB;
constexpr size_t P_S5_X = 136 * MiB;
constexpr size_t P_S5_H = 170 * MiB;

constexpr int NTHREADS = 512;
constexpr int LDS_BYTES = 160 * 1024;

__device__ __forceinline__ unsigned pk2(float lo, float hi) { f32x2 v = {lo, hi}; bf16x2_t b = __builtin_convertvector(v, bf16x2_t); return __builtin_bit_cast(unsigned, b); }
__device__ __forceinline__ float bflo(unsigned w) { return __uint_as_float(w << 16); }
__device__ __forceinline__ float bfhi(unsigned w) { return __uint_as_float(w & 0xffff0000u); }
__device__ __forceinline__ float wave_sum(float v) {
#pragma unroll
    for (int o = 1; o < 64; o <<= 1) v += __shfl_xor(v, o);
    return v;
}
__device__ __forceinline__ float fexp2(float x) { return __builtin_amdgcn_exp2f(x); }
__device__ __forceinline__ float siluf(float x) { return x / (1.f + fexp2(-x * LOG2E)); }
__device__ __forceinline__ float sigmf(float x) { return 1.f / (1.f + fexp2(-x * LOG2E)); }
__device__ __forceinline__ float gelu_tanh(float x) {
    const float z = 0.7978845608028654f * (x + 0.044715f * x * x * x);
    const float t = fexp2(z * (2.f * LOG2E));
    const float th = 1.f - 2.f / (t + 1.f);
    return 0.5f * x * (1.f + th);
}
__device__ __forceinline__ void sincos_cw(float x, float& s, float& c) {
    const float n = rintf(x * 0.6366197723675814f);
    float r = fmaf(-n, 1.5703125f, x);
    r = fmaf(-n, 4.837512969970703125e-4f, r);
    r = fmaf(-n, 7.54978995489188216e-8f, r);
    const float r2 = r * r;
    const float sp = r + r * r2 * (-1.6666666667e-1f + r2 * (8.3333333333e-3f + r2 * (-1.9841269841e-4f + r2 * 2.7557319224e-6f)));
    const float cp = 1.f + r2 * (-0.5f + r2 * (4.1666666667e-2f + r2 * (-1.3888888889e-3f + r2 * (2.4801587302e-5f + r2 * -2.7557319224e-7f))));
    const int q = ((int)n) & 3;
    s = (q == 0) ? sp : (q == 1) ? cp : (q == 2) ? -sp : -cp;
    c = (q == 0) ? cp : (q == 1) ? -sp : (q == 2) ? -cp : sp;
}
__device__ __forceinline__ f32x16 mfma32(bf16x8 a, bf16x8 b, f32x16 c) { return __builtin_amdgcn_mfma_f32_32x32x16_bf16(a, b, c, 0, 0, 0); }
__device__ __forceinline__ f32x4 mfma16(bf16x8 a, bf16x8 b, f32x4 c) { return __builtin_amdgcn_mfma_f32_16x16x32_bf16(a, b, c, 0, 0, 0); }
typedef short v4i16_t __attribute__((ext_vector_type(4)));
__device__ __forceinline__ s16x4 tr4(cldsp p) { return __builtin_bit_cast(s16x4, __builtin_amdgcn_ds_read_tr16_b64_v4i16((LAS v4i16_t*)p)); }
__device__ __forceinline__ bf16x8 cat8(s16x4 lo, s16x4 hi) { return (bf16x8){lo[0], lo[1], lo[2], lo[3], hi[0], hi[1], hi[2], hi[3]}; }
template <int s8> __device__ __forceinline__ bf16x8 pack8(const f32x16& x) {
    u32x4 p;
    p[0] = pk2(x[s8 + 0], x[s8 + 1]); p[1] = pk2(x[s8 + 2], x[s8 + 3]); p[2] = pk2(x[s8 + 4], x[s8 + 5]); p[3] = pk2(x[s8 + 6], x[s8 + 7]);
    return __builtin_bit_cast(bf16x8, p);
}
__device__ __forceinline__ int crow(int reg, int h) { return (reg & 3) + 8 * (reg >> 2) + 4 * h; }
__device__ __forceinline__ float max3f(float a, float b, float c) { return __builtin_fmaxf(__builtin_fmaxf(a, b), c); }
namespace pg8 {
#define PG8_LAS __attribute__((address_space(3)))
typedef unsigned short bf16_t;
typedef short bf16x8 __attribute__((ext_vector_type(8)));
typedef float f32x4 __attribute__((ext_vector_type(4)));
typedef unsigned u32x4 __attribute__((ext_vector_type(4)));
constexpr int BM = 256, BK = 64, HALF = 128, HTB = HALF * BK * 2  , STAGE_BYTES = 8 * HTB, NXCD = 8, WGM = 8;

__host__ __device__ __forceinline__ int lds_byte(int r, int c) { const int st = (r >> 4) * 2 + (c >> 5), rr = r & 15, cc = c & 31, ob = rr * 64 + cc * 2; return st * 1024 + (ob ^ (((ob >> 9) & 1) << 5)); }
__host__ __device__ __forceinline__ void stage_rc(int b, int& R, int& C) { const int st = b / 1024, sb = b % 1024, swz = sb ^ (((sb >> 9) & 1) << 5); R = (st >> 1) * 16 + swz / 64; C = (st & 1) * 32 + (swz % 64) / 2; }
__host__ __device__ __forceinline__ int perm32(int rho) { const int n = rho >> 4, i = rho & 15; return 8 * (i >> 2) + 4 * n + (i & 3); }

struct Unit { int pm, pn; };
struct Gemm { const bf16_t* A; const bf16_t* Bt; int M, N, K; };

struct StaticOrder {
    int nM, nN, nwg, G, c;
    __host__ __device__ void init(int M, int N, int G_, int c_) { nM = M / BM; nN = N / BM; nwg = nM * nN; G = G_; c = c_; }
    __host__ __device__ bool next(int i, Unit& u) const {
        const long L = (long)i * G + c; if (L >= nwg) return false;
        int wgid = (int)L; { const int q = nwg / NXCD, r = nwg % NXCD, xcd = wgid % NXCD, off = wgid / NXCD; wgid = (xcd < r ? xcd * (q + 1) : r * (q + 1) + (xcd - r) * q) + off; }
        const int nig = WGM * nN, gid = wgid / nig, fm = gid * WGM, gsz = (nM - fm) < WGM ? (nM - fm) : WGM;
        u.pm = fm + ((wgid % nig) % gsz); u.pn = (wgid % nig) / gsz; return true;
    }
    __device__ __forceinline__ void a_ready(const Unit&) const {}
    __device__ __forceinline__ void done(const Unit&) const {}
};
__device__ __forceinline__ unsigned cvt_pk_bf16(float lo, float hi) { unsigned r; asm volatile("v_cvt_pk_bf16_f32 %0, %1, %2" : "=v"(r) : "v"(lo), "v"(hi)); return r; }
template <class Epi, class Sched, bool ALIGN_EPI = false, bool SP2 = false>
__device__ __forceinline__ void gemm_phase(PG8_LAS unsigned char* lds, const Gemm g, const Sched& S, const Epi& E) {
    int tid = threadIdx.x; asm volatile("" : "+v"(tid));
    const int wid = __builtin_amdgcn_readfirstlane(tid >> 6), lane = tid & 63, wr = wid >> 2, wc = wid & 3, fr = lane & 15, fq = lane >> 4;
    const int K = g.K, nt = K / BK;
    unsigned voffA[2], voffB[2];
#pragma unroll
    for (int i = 0; i < 2; ++i) { int R, C; stage_rc(tid * 16 + i * 8192, R, C); const int Rb = Epi::PERM ? ((R & ~31) + perm32(R & 31)) : R;
        voffA[i] = (unsigned)(R * K + C) * 2u; voffB[i] = (unsigned)(Rb * K + C) * 2u; }
    const size_t kstep = (size_t)(BK * 2);
    const size_t hstep = (size_t)HALF * K * 2;
    const size_t tstep = 2 * hstep;
    const unsigned ldsw = (unsigned)wid * 1024u;
    const int aoff = lds_byte(wr * 64 + fr, fq * 8), boff = lds_byte(wc * 32 + fr, fq * 8);
#define PG8_SA(b, h) (((b) * 2 + (h)) * HTB)
#define PG8_SB(b, h) ((4 + (b) * 2 + (h)) * HTB)
#define PG8_STAGE(bufoff, gbase, voff) do { _Pragma("unroll") for (int _i = 0; _i < 2; ++_i) \
        __builtin_amdgcn_global_load_lds((const unsigned*)((const char*)(gbase) + (voff)[_i]), (PG8_LAS unsigned*)(lds + (bufoff) + ldsw + _i * 8192), 16, 0, 0); } while (0)
#define PG8_LDA(dst, b, h) do { _Pragma("unroll") for (int m = 0; m < 4; ++m) _Pragma("unroll") for (int k = 0; k < 2; ++k) dst[m][k] = *(const PG8_LAS bf16x8*)(lds + PG8_SA(b, h) + aoff + m * 2048 + k * 1024); } while (0)
#define PG8_LDB(dst, b, h) do { _Pragma("unroll") for (int n = 0; n < 2; ++n) _Pragma("unroll") for (int k = 0; k < 2; ++k) dst[n][k] = *(const PG8_LAS bf16x8*)(lds + PG8_SB(b, h) + boff + n * 2048 + k * 1024); } while (0)
#define PG8_MMA(ai, bj, At, Bt) do { __builtin_amdgcn_s_setprio(1); _Pragma("unroll") for (int m = 0; m < 4; ++m) _Pragma("unroll") for (int n = 0; n < 2; ++n) _Pragma("unroll") for (int k = 0; k < 2; ++k) \
        acc[ai][bj][m][n] = __builtin_amdgcn_mfma_f32_16x16x32_bf16(Bt[n][k], At[m][k], acc[ai][bj][m][n], 0, 0, 0); __builtin_amdgcn_s_setprio(0); } while (0)
#define PG8_WAIT_V(n) asm volatile("s_waitcnt vmcnt(" #n ")" ::: "memory")
#define PG8_WAIT_L(n) asm volatile("s_waitcnt lgkmcnt(" #n ")" ::: "memory")
#define PG8_BAR __builtin_amdgcn_s_barrier()
#define PG8_SCHED __builtin_amdgcn_sched_barrier(0)
    Unit cur, nxt; int ui = 0;
    if (!S.next(0, cur)) return;
    f32x4 acc[2][2][4][2];
#pragma unroll
    for (int a = 0; a < 2; ++a)
#pragma unroll
        for (int b = 0; b < 2; ++b)
#pragma unroll
            for (int m = 0; m < 4; ++m)
#pragma unroll
                for (int n = 0; n < 2; ++n) acc[a][b][m][n] = (f32x4){0.f, 0.f, 0.f, 0.f};
    bf16x8 At[4][2], B0[2][2], B1[2][2];
    const char* cA = (const char*)g.A + (size_t)cur.pm * tstep; const char* cB = (const char*)g.Bt + (size_t)cur.pn * tstep;
    S.a_ready(cur);
    if constexpr (SP2) {
        PG8_STAGE(PG8_SB(0, 0), cB, voffB); PG8_STAGE(PG8_SB(0, 1), cB + hstep, voffB); PG8_STAGE(PG8_SA(0, 0), cA, voffA); PG8_STAGE(PG8_SA(0, 1), cA + hstep, voffA);
        if (wr == 1) PG8_BAR;
        PG8_WAIT_V(2); PG8_BAR;
        PG8_STAGE(PG8_SB(1, 0), cB + kstep, voffB); PG8_STAGE(PG8_SA(1, 0), cA + kstep, voffA); PG8_STAGE(PG8_SB(1, 1), cB + hstep + kstep, voffB);
        PG8_WAIT_V(6); PG8_BAR;
    } else {
        PG8_STAGE(PG8_SB(0, 0), cB, voffB); PG8_STAGE(PG8_SA(0, 0), cA, voffA); PG8_STAGE(PG8_SB(0, 1), cB + hstep, voffB); PG8_STAGE(PG8_SA(0, 1), cA + hstep, voffA);
        if (wr == 1) PG8_BAR;
        PG8_WAIT_V(4); PG8_BAR;
        PG8_STAGE(PG8_SB(1, 0), cB + kstep, voffB); PG8_STAGE(PG8_SA(1, 0), cA + kstep, voffA); PG8_STAGE(PG8_SB(1, 1), cB + hstep + kstep, voffB);
        PG8_WAIT_V(6); PG8_BAR;
    }
    for (;;) {
        const bool has_next = S.next(ui + 1, nxt);
        const char* nA = has_next ? (const char*)g.A + (size_t)nxt.pm * tstep : cA; const char* nB = has_next ? (const char*)g.Bt + (size_t)nxt.pn * tstep : cB;
        for (int t = 0; t < nt; t += 2) {
            const bool last = (t == nt - 2);
            const char* a1 = cA + (size_t)(t + 1) * kstep;
            const char* a2 = last ? nA : cA + (size_t)(t + 2) * kstep; const char* b2 = last ? nB : cB + (size_t)(t + 2) * kstep;
            const char* a3 = a2 + kstep; const char* b3 = b2 + kstep;
            if (last && has_next) S.a_ready(nxt);
            if constexpr (SP2) {
            PG8_LDB(B0, 0, 0); PG8_LDB(B1, 0, 1); PG8_SCHED; PG8_LDA(At, 0, 0); PG8_STAGE(PG8_SA(1, 1), a1 + hstep, voffA);
            PG8_WAIT_V(8); PG8_WAIT_L(0); PG8_BAR; PG8_MMA(0, 0, At, B0); PG8_MMA(0, 1, At, B1); PG8_BAR; PG8_SCHED;
            PG8_LDA(At, 0, 1); PG8_STAGE(PG8_SB(0, 0), b2, voffB); PG8_STAGE(PG8_SB(0, 1), b2 + hstep, voffB); PG8_STAGE(PG8_SA(0, 0), a2, voffA);
            PG8_WAIT_V(8); PG8_WAIT_L(0); PG8_BAR; PG8_MMA(1, 0, At, B0); PG8_MMA(1, 1, At, B1); PG8_BAR; PG8_SCHED;
            PG8_LDB(B0, 1, 0); PG8_LDB(B1, 1, 1); PG8_SCHED; PG8_LDA(At, 1, 0); PG8_STAGE(PG8_SA(0, 1), a2 + hstep, voffA);
            PG8_WAIT_V(8); PG8_WAIT_L(0); PG8_BAR; PG8_MMA(0, 0, At, B0); PG8_MMA(0, 1, At, B1); PG8_BAR; PG8_SCHED;
            PG8_LDA(At, 1, 1); PG8_STAGE(PG8_SB(1, 0), b3, voffB); PG8_STAGE(PG8_SB(1, 1), b3 + hstep, voffB); PG8_STAGE(PG8_SA(1, 0), a3, voffA);
            PG8_WAIT_V(8); PG8_WAIT_L(0); PG8_BAR; PG8_MMA(1, 0, At, B0); PG8_MMA(1, 1, At, B1); PG8_BAR; PG8_SCHED;
            } else {
            PG8_LDB(B0, 0, 0); PG8_SCHED; PG8_LDA(At, 0, 0); PG8_STAGE(PG8_SA(1, 1), a1 + hstep, voffA);
            PG8_WAIT_L(8); PG8_BAR; PG8_WAIT_L(0); PG8_MMA(0, 0, At, B0); PG8_BAR; PG8_SCHED;
            PG8_LDB(B1, 0, 1); PG8_STAGE(PG8_SB(0, 0), b2, voffB);
            PG8_BAR; PG8_WAIT_L(0); PG8_MMA(0, 1, At, B1); PG8_BAR;
            PG8_LDA(At, 0, 1); PG8_STAGE(PG8_SA(0, 0), a2, voffA);
            PG8_BAR; PG8_WAIT_L(0); PG8_MMA(1, 0, At, B0); PG8_BAR; PG8_SCHED;
            PG8_STAGE(PG8_SB(0, 1), b2 + hstep, voffB);
            PG8_WAIT_V(6); PG8_BAR; PG8_MMA(1, 1, At, B1); PG8_BAR;
            PG8_LDB(B0, 1, 0); PG8_SCHED; PG8_LDA(At, 1, 0); PG8_STAGE(PG8_SA(0, 1), a2 + hstep, voffA);
            PG8_WAIT_L(8); PG8_BAR; PG8_WAIT_L(0); PG8_MMA(0, 0, At, B0); PG8_BAR; PG8_SCHED;
            PG8_LDB(B1, 1, 1); PG8_STAGE(PG8_SB(1, 0), b3, voffB);
            PG8_BAR; PG8_WAIT_L(0); PG8_MMA(0, 1, At, B1); PG8_BAR;
            PG8_LDA(At, 1, 1); PG8_STAGE(PG8_SA(1, 0), a3, voffA);
            PG8_BAR; PG8_WAIT_L(0); PG8_MMA(1, 0, At, B0); PG8_BAR; PG8_SCHED;
            PG8_STAGE(PG8_SB(1, 1), b3 + hstep, voffB);
            PG8_WAIT_V(6); PG8_BAR; PG8_MMA(1, 1, At, B1); PG8_BAR;
            }
        }
        if constexpr (ALIGN_EPI) { if (wr == 0) PG8_BAR; }
        if constexpr (!Epi::AFTER_DRAIN) { E(acc, cur, wr, wc, fr, fq); S.done(cur); }
        if (!has_next) break;
#pragma unroll
        for (int a = 0; a < 2; ++a)
#pragma unroll
            for (int b = 0; b < 2; ++b)
#pragma unroll
                for (int m = 0; m < 4; ++m)
#pragma unroll
                    for (int n = 0; n < 2; ++n) acc[a][b][m][n] = (f32x4){0.f, 0.f, 0.f, 0.f};
        cur = nxt; cA = nA; cB = nB; ++ui;
        if constexpr (ALIGN_EPI) { if (wr == 1) PG8_BAR; }
    }
    PG8_WAIT_V(0);
    if constexpr (!ALIGN_EPI) { if (wr == 0) PG8_BAR; }
    PG8_BAR;
    if constexpr (Epi::AFTER_DRAIN) { E.fused(acc, cur, wr, wc, fr, fq, lds, wid, lane); S.done(cur); }
#undef PG8_SA
#undef PG8_SB
#undef PG8_STAGE
#undef PG8_LDA
#undef PG8_LDB
#undef PG8_MMA
#undef PG8_WAIT_V
#undef PG8_WAIT_L
#undef PG8_BAR
#undef PG8_SCHED
}
}
#define XB_TMO      128
#define XB_XCNT(j)  (256  + 64 * (j))
#define XB_XSUB(j)  (1280 + 64 * (j))
#define XB_XGEN(j)  (2304 + 64 * (j))
#define XB_TOP      3328
#define XB_TOPGEN   3392
#define XCD_BAR_WORDS 3456
#define XB_SPIN_CAP (1u << 18)

__device__ __forceinline__ unsigned xb_ld(unsigned* p)              { return __hip_atomic_load(p, __ATOMIC_RELAXED, __HIP_MEMORY_SCOPE_AGENT); }
__device__ __forceinline__ unsigned xb_add(unsigned* p, unsigned v) { return __hip_atomic_fetch_add(p, v, __ATOMIC_RELAXED, __HIP_MEMORY_SCOPE_AGENT); }
__device__ __forceinline__ unsigned xb_xcc_id() { return (unsigned)__builtin_amdgcn_s_getreg((3 << 11) | 20) & 0xFu; }
#define XB_SPIN(cond, bar) do { unsigned _sp = 0; while (cond) { __builtin_amdgcn_s_sleep(1); \
    if ((++_sp & 255u) == 0u) { if (xb_ld(&(bar)[XB_TMO])) break; if (_sp > XB_SPIN_CAP) { atomicAdd(&(bar)[XB_TMO], 1u); break; } } } } while (0)

struct XcdBarrier {
    unsigned* bar; unsigned x;
    volatile LAS unsigned* st;
};

__device__ __forceinline__ XcdBarrier xcd_barrier_post(unsigned* bar, volatile LAS unsigned* st) {
    XcdBarrier b; b.bar = bar; b.x = xb_xcc_id(); b.st = st;
    if (threadIdx.x == 0) (void)xb_add(&bar[XB_XCNT(b.x)], 1u);
    return b;
}
__device__ __forceinline__ void xcd_barrier_complete(unsigned* bar, unsigned x, unsigned& nloc, unsigned& nx) {
    const unsigned G = gridDim.x * gridDim.y * gridDim.z;
    unsigned sum, cnt, mine, sp = 0u;
    for (;;) {
        sum = 0u; cnt = 0u; mine = 0u;
#pragma unroll
        for (unsigned j = 0; j < 16; ++j) { const unsigned c = xb_ld(&bar[XB_XCNT(j)]); sum += c; cnt += (c > 0u) ? 1u : 0u; mine = (j == x) ? c : mine; }
        if (sum == G) break;
        __builtin_amdgcn_s_sleep(1);
        if ((++sp & 255u) == 0u) { if (xb_ld(&bar[XB_TMO])) break; if (sp > XB_SPIN_CAP) { atomicAdd(&bar[XB_TMO], 1u); break; } }
    }
    nloc = mine > 0u ? mine : 1u; nx = cnt > 0u ? cnt : 1u;
}

__device__ __forceinline__ void xcd_barrier(const XcdBarrier& b) {
    asm volatile("s_waitcnt vmcnt(0)" ::: "memory");
    __syncthreads();
    if (threadIdx.x == 0) {
        unsigned* bar = b.bar;
        __builtin_amdgcn_s_waitcnt(0);
        unsigned nloc = b.st[0], nx = b.st[1];
        if (nloc == 0u) { xcd_barrier_complete(bar, b.x, nloc, nx); b.st[0] = nloc; b.st[1] = nx; }
        const unsigned old = xb_add(&bar[XB_XSUB(b.x)], 1u);
        const unsigned gen = old / nloc;
        if (old + 1u == (gen + 1u) * nloc) {
            __builtin_amdgcn_fence(__ATOMIC_RELEASE, "agent");
            asm volatile("s_waitcnt vmcnt(0)" ::: "memory");
            const unsigned og = xb_add(&bar[XB_TOP], 1u);
            const unsigned tg = og / nx;
            if (og + 1u == (tg + 1u) * nx) xb_add(&bar[XB_TOPGEN], 1u);
            else XB_SPIN(xb_ld(&bar[XB_TOPGEN]) == tg, bar);
            __builtin_amdgcn_fence(__ATOMIC_ACQUIRE, "agent");
            xb_add(&bar[XB_XGEN(b.x)], 1u);
            asm volatile("s_waitcnt vmcnt(0)" ::: "memory");
        } else {
            XB_SPIN(xb_ld(&bar[XB_XGEN(b.x)]) == gen, bar);
            __builtin_amdgcn_fence(__ATOMIC_ACQUIRE, "agent");
            asm volatile("s_waitcnt vmcnt(0)" ::: "memory");
        }
    }
    __syncthreads();
}


typedef f32x4 acc_t[2][2][4][2];

struct EpiStore {
    static constexpr bool PERM = true, AFTER_DRAIN = false;
    bf16* O; int ldc;
    __device__ __forceinline__ void operator()(const acc_t& acc, const pg8::Unit& u, int wr, int wc, int fr, int fq) const {
        const int row0 = u.pm * 256 + wr * 64 + fr, col0 = u.pn * 256 + wc * 32 + 8 * fq;
#pragma unroll
        for (int ai = 0; ai < 2; ++ai)
#pragma unroll
            for (int m = 0; m < 4; ++m) {
                bf16* rowp = O + (size_t)(row0 + ai * 128 + m * 16) * ldc + col0;
#pragma unroll
                for (int bj = 0; bj < 2; ++bj) {
                    const f32x4 v0 = acc[ai][bj][m][0], v1 = acc[ai][bj][m][1];
                    u32x4 w; w.x = pk2(v0[0], v0[1]); w.y = pk2(v0[2], v0[3]); w.z = pk2(v1[0], v1[1]); w.w = pk2(v1[2], v1[3]);
                    *(u32x4*)(rowp + bj * 128) = w;
                }
            }
    }
};
struct EpiRetGate {
    static constexpr bool PERM = true, AFTER_DRAIN = false;
    bf16* O; int ldc;
    __device__ __forceinline__ void operator()(const acc_t& acc, const pg8::Unit& u, int wr, int wc, int fr, int fq) const {
        const int row0 = u.pm * 256 + wr * 64 + fr, col0 = u.pn * 256 + wc * 32 + 8 * fq;
#pragma unroll
        for (int ai = 0; ai < 2; ++ai)
#pragma unroll
            for (int m = 0; m < 4; ++m) {
                bf16* rowp = O + (size_t)(row0 + ai * 128 + m * 16) * ldc + col0;
#pragma unroll
                for (int bj = 0; bj < 2; ++bj) {
                    const f32x4 v0 = acc[ai][bj][m][0], v1 = acc[ai][bj][m][1];
                    const u32x4 o = *(const u32x4*)(rowp + bj * 128);
                    u32x4 w;
                    w.x = pk2(siluf(v0[0]) * bflo(o.x), siluf(v0[1]) * bfhi(o.x)); w.y = pk2(siluf(v0[2]) * bflo(o.y), siluf(v0[3]) * bfhi(o.y));
                    w.z = pk2(siluf(v1[0]) * bflo(o.z), siluf(v1[1]) * bfhi(o.z)); w.w = pk2(siluf(v1[2]) * bflo(o.w), siluf(v1[3]) * bfhi(o.w));
                    *(u32x4*)(rowp + bj * 128) = w;
                }
            }
    }
};
template <int ACT  > struct EpiPair {
    static constexpr bool PERM = false, AFTER_DRAIN = false;
    bf16* O; int ldc;
    __device__ __forceinline__ void operator()(const acc_t& acc, const pg8::Unit& u, int wr, int wc, int fr, int fq) const {
        const int row0 = u.pm * 256 + wr * 64 + fr;
#pragma unroll
        for (int ai = 0; ai < 2; ++ai)
#pragma unroll
            for (int m = 0; m < 4; ++m) {
                bf16* rowp = O + (size_t)(row0 + ai * 128 + m * 16) * ldc;
#pragma unroll
                for (int bj = 0; bj < 2; ++bj) {
                    const int col = 16 * (u.pn * 8 + 4 * bj + wc) + 4 * fq;
                    const f32x4 a = acc[ai][bj][m][0], b = acc[ai][bj][m][1];
                    float t[4];
#pragma unroll
                    for (int e = 0; e < 4; ++e) t[e] = (ACT == 0) ? siluf(a[e]) * b[e] : a[e] * sigmf(b[e]);
                    u32x2 w; w.x = pk2(t[0], t[1]); w.y = pk2(t[2], t[3]);
                    *(u32x2*)(rowp + col) = w;
                }
            }
    }
};
struct EpiAttnIn {
    static constexpr bool PERM = false, AFTER_DRAIN = false;
    bf16* O; const float* rope;
    __device__ __forceinline__ void operator()(const acc_t& acc, const pg8::Unit& u, int wr, int wc, int fr, int fq) const {
        const int row0 = u.pm * 256 + wr * 64 + fr, part = u.pn >> 2;
        const bool lat = u.pm < 64;
        const float sc = (part == 0) ? 0.125f * LOG2E : 1.f;
#pragma unroll
        for (int ai = 0; ai < 2; ++ai)
#pragma unroll
            for (int m = 0; m < 4; ++m) {
                const int row = row0 + ai * 128 + m * 16;
                bf16* rowp = O + (size_t)row * 3072 + u.pn * 256 + wc * 32 + 4 * fq;
                f32x4 cs0 = {1.f, 0.f, 1.f, 0.f}, cs1 = {1.f, 0.f, 1.f, 0.f};
                if (part < 2 && lat) {
                    const int s = row & 8191, pos = (wc & 1) ? (s & 63) : (s >> 6);
                    const f32x4* tp = (const f32x4*)(rope + (size_t)(pos * 16 + 4 * fq) * 2);
                    cs0 = tp[0]; cs1 = tp[1];
                }
#pragma unroll
                for (int bj = 0; bj < 2; ++bj) {
                    const f32x4 x0 = acc[ai][bj][m][0], x1 = acc[ai][bj][m][1];
                    f32x4 o0, o1;
                    if (part < 2) {
                        const float c[4] = {cs0[0], cs0[2], cs1[0], cs1[2]}, sn[4] = {cs0[1], cs0[3], cs1[1], cs1[3]};
#pragma unroll
                        for (int e = 0; e < 4; ++e) { o0[e] = (x0[e] * c[e] - x1[e] * sn[e]) * sc; o1[e] = (x1[e] * c[e] + x0[e] * sn[e]) * sc; }
                    } else { o0 = x0; o1 = x1; }
                    u32x2 w0, w1; w0.x = pk2(o0[0], o0[1]); w0.y = pk2(o0[2], o0[3]); w1.x = pk2(o1[0], o1[1]); w1.y = pk2(o1[2], o1[3]);
                    *(u32x2*)(rowp + bj * 128) = w0; *(u32x2*)(rowp + bj * 128 + 16) = w1;
                }
            }
    }
};
struct EpiRetIn {
    static constexpr bool PERM = false, AFTER_DRAIN = false;
    bf16* O; const float* rope;
    __device__ __forceinline__ void operator()(const acc_t& acc, const pg8::Unit& u, int wr, int wc, int fr, int fq) const {
        const int row0 = u.pm * 256 + wr * 64 + fr, part = u.pn >> 2;
        const bool lat = u.pm < 64;
        const float sc = (part == 1) ? 0.0625f : 1.f;
#pragma unroll
        for (int ai = 0; ai < 2; ++ai)
#pragma unroll
            for (int m = 0; m < 4; ++m) {
                const int row = row0 + ai * 128 + m * 16;
                bf16* rowp = O + (size_t)row * 4096 + u.pn * 256 + wc * 32 + 4 * fq;
                const int s = row & 8191;
#pragma unroll
                for (int bj = 0; bj < 2; ++bj) {
                    const f32x4 x0 = acc[ai][bj][m][0], x1 = acc[ai][bj][m][1];
                    f32x4 o0, o1;
                    if (part < 2) {
                        f32x4 cs0 = {1.f, 0.f, 1.f, 0.f}, cs1 = {1.f, 0.f, 1.f, 0.f};
                        if (lat) {
                            const int pos = bj ? (s & 63) : (s >> 6);
                            const f32x4* tp = (const f32x4*)(rope + (size_t)(pos * 64 + 16 * wc + 4 * fq) * 2);
                            cs0 = tp[0]; cs1 = tp[1];
                        }
                        const float c[4] = {cs0[0], cs0[2], cs1[0], cs1[2]}, sn[4] = {cs0[1], cs0[3], cs1[1], cs1[3]};
#pragma unroll
                        for (int e = 0; e < 4; ++e) { o0[e] = (x0[e] * c[e] - x1[e] * sn[e]) * sc; o1[e] = (x1[e] * c[e] + x0[e] * sn[e]) * sc; }
                    } else { o0 = x0; o1 = x1; }
                    u32x2 w0, w1; w0.x = pk2(o0[0], o0[1]); w0.y = pk2(o0[2], o0[3]); w1.x = pk2(o1[0], o1[1]); w1.y = pk2(o1[2], o1[3]);
                    *(u32x2*)(rowp + bj * 128) = w0; *(u32x2*)(rowp + bj * 128 + 16) = w1;
                }
            }
    }
};

template <class Epi> __device__ __forceinline__ void run_gemm(ldsp lds, const bf16* A, const bf16* Bt, int Mrows, int N, int K, const Epi& E) {
    pg8::Gemm g{A, Bt, Mrows, N, K}; pg8::StaticOrder S; S.init(Mrows, N, (int)gridDim.x, (int)blockIdx.x);
    pg8::gemm_phase<Epi, pg8::StaticOrder, true, true>(lds, g, S, E);
}

__device__ __forceinline__ int dest_row(int mode, int half, int c) {
    if (mode == 1) return 32 * (c >> 4) + 16 * half + (c & 15);
    if (mode == 2 && c < 2048) { const int cl = c & 255, seg = cl >> 7, hf = (cl >> 6) & 1, j = cl & 63; return (c - cl) + 32 * (seg * 4 + (j >> 4)) + 16 * hf + (j & 15); }
    return c;
}
__device__ __forceinline__ void conv_w(const float* __restrict__ W, int ldw, int K, int ncols, bf16* __restrict__ WT, int mode, int half, ldsp lds, int gw, int ngw, int lane, int wave) {
    LAS float* scr = (LAS float*)(lds + wave * 16384);
    const int nblk = ncols / 32, nitems = (K / 64) * nblk;
    for (int it = gw; it < nitems; it += ngw) {
        const int kb = it / nblk, nb = it % nblk, k0 = 64 * kb, n0 = 32 * nb;
#pragma unroll 8
        for (int i = 0; i < 32; ++i) { const int kk = 2 * i + (lane >> 5); scr[kk * 33 + (lane & 31)] = __builtin_nontemporal_load(&W[(size_t)(k0 + kk) * ldw + n0 + (lane & 31)]); }
        asm volatile("s_waitcnt lgkmcnt(0)" ::: "memory");
        const int c = lane & 7;
#pragma unroll
        for (int j = 0; j < 4; ++j) {
            const int n = (lane >> 3) + 8 * j; const LAS float* s = scr + (8 * c) * 33 + n;
            u32x4 o; o.x = pk2(s[0 * 33], s[1 * 33]); o.y = pk2(s[2 * 33], s[3 * 33]); o.z = pk2(s[4 * 33], s[5 * 33]); o.w = pk2(s[6 * 33], s[7 * 33]);
            *(u32x4*)(WT + (size_t)dest_row(mode, half, n0 + n) * K + k0 + 8 * c) = o;
        }
        asm volatile("s_waitcnt lgkmcnt(0)" ::: "memory");
    }
}

struct Params { const float* in[26]; float* out; unsigned char* ws; int ph_lo, ph_hi; };
enum { I_X = 0, I_C, I_CTX, I_CCTX, I_MODW, I_MODB, I_NORMG, I_AWIN, I_AWOUT, I_ALAM, I_ASUBLN, I_RWIN, I_RWOUT, I_RDECAY, I_SLRE, I_SLIM, I_SLOGDT,
       I_SBRE, I_SBIM, I_SCRE, I_SCIM, I_SD, I_SWGLU, I_FWG, I_FWU, I_FWD };

__device__ __forceinline__ void conv_layer(const Params& p, int l, ldsp lds, int gw, int ngw, int lane, int wave) {
    bf16* Wb = (bf16*)(p.ws + WS_W);
    const int kind = l % 3, j = l / 3;
    if (kind == 0) {
        conv_w(p.in[I_AWIN] + (size_t)j * D * 3072, 3072, D, 3072, Wb + W_IN, 0, 0, lds, gw, ngw, lane, wave);
        conv_w(p.in[I_AWOUT] + (size_t)j * D * D, D, D, D, Wb + W_OUT, 0, 0, lds, gw, ngw, lane, wave);
    } else if (kind == 1) {
        conv_w(p.in[I_RWIN], 6144, D, 4096, Wb + W_IN, 2, 0, lds, gw, ngw, lane, wave);
        conv_w(p.in[I_RWIN] + 4096, 6144, D, 2048, Wb + W_G, 0, 0, lds, gw, ngw, lane, wave);
        conv_w(p.in[I_RWOUT], D, 2048, D, Wb + W_OUT, 0, 0, lds, gw, ngw, lane, wave);
    } else {
        conv_w(p.in[I_SWGLU], 2048, D, 1024, Wb + W_OUT, 1, 0, lds, gw, ngw, lane, wave);
        conv_w(p.in[I_SWGLU] + 1024, 2048, D, 1024, Wb + W_OUT, 1, 1, lds, gw, ngw, lane, wave);
    }
    conv_w(p.in[I_FWG] + (size_t)l * D * FF, FF, D, FF, Wb + W_GU, 1, 0, lds, gw, ngw, lane, wave);
    conv_w(p.in[I_FWU] + (size_t)l * D * FF, FF, D, FF, Wb + W_GU, 1, 1, lds, gw, ngw, lane, wave);
    conv_w(p.in[I_FWD] + (size_t)l * FF * D, D, FF, D, Wb + W_DN, 0, 0, lds, gw, ngw, lane, wave);
}

__device__ __forceinline__ void mods_phase(const Params& p, ldsp lds, int tid) {
    LAS float* sil = (LAS float*)lds;
    LAS float* red = sil + 3 * 1024;
    for (int i = tid; i < 3072; i += NTHREADS) { const float v = (i < 2048) ? p.in[I_C][i] : p.in[I_CCTX][i - 2048]; sil[i] = siluf(v); }
    __syncthreads();
    float* modv = (float*)(p.ws + WS_MOD);
    const int ks = tid >> 6, c = tid & 63;
    for (int u = blockIdx.x; u < 4 * 96; u += gridDim.x) {
        const int l = u / 96, col = (u % 96) * 64 + c;
        const float* w = p.in[I_MODW] + (size_t)l * D * 6144 + col;
        float a0 = 0.f, a1 = 0.f, a2 = 0.f;
#pragma unroll 8
        for (int k = ks * 128; k < ks * 128 + 128; ++k) { const float wv = __builtin_nontemporal_load(&w[(size_t)k * 6144]); a0 += sil[k] * wv; a1 += sil[1024 + k] * wv; a2 += sil[2048 + k] * wv; }
        red[(ks * 3 + 0) * 64 + c] = a0; red[(ks * 3 + 1) * 64 + c] = a1; red[(ks * 3 + 2) * 64 + c] = a2;
        __syncthreads();
        if (tid < 192) {
            const int set = tid >> 6; float s = 0.f;
#pragma unroll
            for (int k = 0; k < 8; ++k) s += red[(k * 3 + set) * 64 + c];
            modv[((size_t)l * 3 + set) * 6144 + col] = s + p.in[I_MODB][l * 6144 + col];
        }
        __syncthreads();
    }
}
__device__ __forceinline__ void rope_tables(const Params& p, int gtid, int ngt) {
    float* ra = (float*)(p.ws + WS_ROPEA); float* rr = (float*)(p.ws + WS_ROPER);
    for (int i = gtid; i < 128 * 80; i += ngt) {
        const int pos = i / 80, jj = i % 80;
        const bool isA = jj < 16; const int j = isA ? jj : jj - 16; const float quarter = isA ? 16.f : 64.f;
        const float freq = exp2f(-(float)j / quarter * 13.287712379549449f);
        float s, c; sincos_cw((float)pos * freq, s, c);
        float* dst = isA ? ra + (pos * 16 + j) * 2 : rr + (pos * 64 + j) * 2;
        dst[0] = c; dst[1] = s;
    }
}

__device__ __forceinline__ void rows_phase(const Params& p, int mode, int nrows, const float* gA, int lm_gate, int gate_idx, bool make_u, const float* gB, int lm_u, int shift_idx, int gw, int ngw, int lane, bool final_out = false) {
    const float* modv = (const float*)(p.ws + WS_MOD);
    bf16* UY = (bf16*)(p.ws + WS_UY);
    bf16* HB = (bf16*)(p.ws + WS_HB);
    for (int row = gw; row < nrows; row += ngw) {
        const int set = row < 8192 ? 0 : (row < ML ? 1 : 2);
        bf16* hrow = HB + (size_t)row * D;
        f32x4 h[4];
        if (mode == 0) {
            const float* src = row < ML ? p.in[I_X] + (size_t)row * D : p.in[I_CTX] + (size_t)(row - ML) * D;
#pragma unroll
            for (int k = 0; k < 4; ++k) h[k] = __builtin_nontemporal_load((const f32x4*)(src + k * 256 + lane * 4));
        } else {
            f32x4 y[4]; float ss = 0.f;
#pragma unroll
            for (int k = 0; k < 4; ++k) {
                const u32x2 w = *(const u32x2*)(UY + (size_t)row * D + k * 256 + lane * 4);
                y[k] = (f32x4){bflo(w.x), bfhi(w.x), bflo(w.y), bfhi(w.y)};
                ss += y[k][0] * y[k][0] + y[k][1] * y[k][1] + y[k][2] * y[k][2] + y[k][3] * y[k][3];
            }
            const float rs = rsqrtf(wave_sum(ss) * (1.f / D) + EPS);
            const float* gate = modv + ((size_t)lm_gate * 3 + set) * 6144 + gate_idx * 1024;
#pragma unroll
            for (int k = 0; k < 4; ++k) {
                const int c0 = k * 256 + lane * 4;
                const u32x2 hw = *(const u32x2*)(hrow + c0); const f32x4 hv = {bflo(hw.x), bfhi(hw.x), bflo(hw.y), bfhi(hw.y)};
                const f32x4 gv = *(const f32x4*)(gA + c0), gt = *(const f32x4*)(gate + c0);
                h[k] = hv + gt * (y[k] * rs * gv);
            }
        }
        if (final_out) {
#pragma unroll
            for (int k = 0; k < 4; ++k) __builtin_nontemporal_store(h[k], (f32x4*)(p.out + (size_t)row * D + k * 256 + lane * 4));
        } else {
#pragma unroll
            for (int k = 0; k < 4; ++k) { u32x2 w; w.x = pk2(h[k][0], h[k][1]); w.y = pk2(h[k][2], h[k][3]); *(u32x2*)(hrow + k * 256 + lane * 4) = w; }
        }
        if (make_u) {
            float ss = 0.f;
#pragma unroll
            for (int k = 0; k < 4; ++k) ss += h[k][0] * h[k][0] + h[k][1] * h[k][1] + h[k][2] * h[k][2] + h[k][3] * h[k][3];
            const float rs = rsqrtf(wave_sum(ss) * (1.f / D) + EPS);
            const float* shift = modv + ((size_t)lm_u * 3 + set) * 6144 + shift_idx * 1024;
            const float* scale = shift + 1024;
#pragma unroll
            for (int k = 0; k < 4; ++k) {
                const int c0 = k * 256 + lane * 4;
                const f32x4 gv = *(const f32x4*)(gB + c0), sh = *(const f32x4*)(shift + c0), sc = *(const f32x4*)(scale + c0);
                const f32x4 v = (h[k] * rs * gv) * (1.f + sc) + sh;
                u32x2 w; w.x = pk2(v[0], v[1]); w.y = pk2(v[2], v[3]);
                *(u32x2*)(UY + (size_t)row * D + c0) = w;
            }
        }
    }
}

template <int K> __device__ __forceinline__ void ctx_gemm(ldsp lds, const bf16* __restrict__ A, const bf16* __restrict__ Bt, bf16* __restrict__ Y) {
    int tid = threadIdx.x; asm volatile("" : "+v"(tid));
    const int lane = tid & 63, wid = __builtin_amdgcn_readfirstlane(tid >> 6), r = lane & 31, hh = lane >> 5;
    constexpr int KQ = K / 8, NS = KQ / 16, NB = (NS % 11 == 0) ? 11 : 8;
    static_assert(NS % NB == 0, "ctx_gemm K split");
    LAS float* red = (LAS float*)lds;
    for (int tile = blockIdx.x; tile < 512; tile += gridDim.x) {
        const int tm = tile >> 5, tn = tile & 31;
        const bf16* ap = A + (size_t)(ML + tm * 32 + r) * K + wid * KQ + hh * 8;
        const bf16* bp = Bt + (size_t)(tn * 32 + r) * K + wid * KQ + hh * 8;
        f32x16 acc;
#pragma unroll
        for (int e = 0; e < 16; ++e) acc[e] = 0.f;
#pragma unroll 1
        for (int s0 = 0; s0 < NS; s0 += NB) {
            bf16x8 af[NB], bfr[NB];
#pragma unroll
            for (int s = 0; s < NB; ++s) { af[s] = *(const bf16x8*)(ap + (s0 + s) * 16); bfr[s] = *(const bf16x8*)(bp + (s0 + s) * 16); }
#pragma unroll
            for (int s = 0; s < NB; ++s) acc = mfma32(af[s], bfr[s], acc);
        }
        __syncthreads();
        LAS float* rp = red + (wid * 32) * 33 + r;
#pragma unroll
        for (int e = 0; e < 16; ++e) rp[crow(e, hh) * 33] = acc[e];
        __syncthreads();
        if (tid < 256) {
            const int row = tid >> 3, c4 = (tid & 7) * 4;
            const LAS float* sp = red + row * 33 + c4;
            float v[4];
#pragma unroll
            for (int e = 0; e < 4; ++e) { float a = 0.f;
#pragma unroll
                for (int k = 0; k < 8; ++k) a += sp[k * 32 * 33 + e];
                v[e] = a; }
            u32x2 w; w.x = pk2(v[0], v[1]); w.y = pk2(v[2], v[3]);
            *(u32x2*)(Y + (size_t)(ML + tm * 32 + row) * D + tn * 32 + c4) = w;
        }
    }
}

constexpr int AT_KST = 272, AT_VST = 320;
constexpr int AT_KBUF = 64 * AT_KST, AT_VBUF = 64 * AT_VST, AT_STAGE = AT_KBUF + AT_VBUF;
static_assert(3 * AT_STAGE <= LDS_BYTES - 64 && 4 * 64 * 64 * 4 <= 3 * AT_STAGE, "attention LDS");

__device__ __forceinline__ void attn_phase(ldsp lds, const bf16* __restrict__ P, bf16* __restrict__ O, const float* lamv, const float* subln, float lam_init, bool with_ctx) {
    int tid = threadIdx.x; asm volatile("" : "+v"(tid));
    const int lane = tid & 63, wid = __builtin_amdgcn_readfirstlane(tid >> 6), r = lane & 31, hh = lane >> 5;
    const int q4 = (lane & 15) >> 2, p4 = lane & 3, blk = (lane >> 4) & 1;
    const int qb = wid & 3, sh = wid >> 2;
    float lam;
    { const float a = lamv[lane] * lamv[64 + lane], b = lamv[128 + lane] * lamv[192 + lane]; lam = expf(wave_sum(a)) - expf(wave_sum(b)) + lam_init; }
    const int G = gridDim.x, bid = blockIdx.x;
    const int vb = (G % 8 == 0) ? (bid % 8) * (G / 8) + bid / 8 : bid;
    const int NU = 1024 + (with_ctx ? 32 : 0);
    const int srow = tid >> 4, sch = tid & 15;
    for (int u = vb; u < NU; u += G) {
        int b, h, qrow0, NT;
        if (u < 1024) { b = u >> 9; h = (u >> 6) & 7; qrow0 = b * SEQ + (u & 63) * 128; NT = 132; }
        else { const int v = u - 1024; b = v >> 4; h = (v >> 1) & 7; qrow0 = ML + b * CTX + (v & 1) * 128; NT = 4; }
        bf16x8 qf[4];
        {
            const bf16* qp = P + (size_t)(qrow0 + qb * 32 + r) * 3072 + h * 128 + sh * 64 + hh * 8;
#pragma unroll
            for (int d0 = 0; d0 < 4; ++d0) qf[d0] = *(const bf16x8*)(qp + d0 * 16);
        }
        f32x16 Oa[4];
#pragma unroll
        for (int d0 = 0; d0 < 4; ++d0)
#pragma unroll
            for (int e = 0; e < 16; ++e) Oa[d0][e] = 0.f;
        float mrun = 0.f, lrun = 0.f, mx;
        f32x16 zero16;
#pragma unroll
        for (int e = 0; e < 16; ++e) zero16[e] = 0.f;
        u32x4 sA[4], sB[4];
        const bf16* gK = P + (size_t)srow * 3072 + 1024 + h * 128 + sch * 8;
        const int ctx0 = ML + b * CTX, lat0 = b * SEQ - 256;
#define AT_TROW(t) ((t) < 4 ? ctx0 + (t) * 64 : lat0 + (t) * 64)
#define AT_LOAD(sreg, t) do { const bf16* g_ = gK + (size_t)AT_TROW(t) * 3072; sreg[0] = *(const u32x4*)g_; sreg[1] = *(const u32x4*)(g_ + 32 * 3072); sreg[2] = *(const u32x4*)(g_ + 1024); sreg[3] = *(const u32x4*)(g_ + 32 * 3072 + 1024); } while (0)
#define AT_STORE(sreg, so) do { ldsp kb_ = lds + (so) + srow * AT_KST + sch * 16; *(LAS u32x4*)kb_ = sreg[0]; *(LAS u32x4*)(kb_ + 32 * AT_KST) = sreg[1]; \
            ldsp vb_ = lds + (so) + AT_KBUF + srow * AT_VST + sch * 16; *(LAS u32x4*)vb_ = sreg[2]; *(LAS u32x4*)(vb_ + 32 * AT_VST) = sreg[3]; } while (0)
#define AT_QK(N0, N1, so, INIT) do { cldsp kb_ = lds + (so) + r * AT_KST + (sh * 64 + hh * 8) * 2; \
            _Pragma("unroll") for (int d0 = 0; d0 < 4; ++d0) { \
                const bf16x8 ka_ = *(const LAS bf16x8*)(kb_ + d0 * 32), kc_ = *(const LAS bf16x8*)(kb_ + 32 * AT_KST + d0 * 32); \
                if (d0 == 0) { N0 = mfma32(ka_, qf[0], zero16); N1 = mfma32(kc_, qf[0], zero16); } \
                else { N0 = mfma32(ka_, qf[d0], N0); N1 = mfma32(kc_, qf[d0], N1); } } } while (0)
#define AT_MAX(N0, N1) do { float ma_, mb_; \
            asm volatile("s_nop 15\n\ts_nop 7\n\tv_max3_f32 %0, %1, %2, %3" : "=v"(ma_) : "v"(N0[0]), "v"(N0[1]), "v"(N1[0])); \
            asm volatile("v_max3_f32 %0, %1, %2, %3" : "=v"(mb_) : "v"(N0[2]), "v"(N0[3]), "v"(N1[1])); \
            asm volatile("v_max3_f32 %0, %1, %2, %3" : "=v"(ma_) : "v"(ma_), "v"(N1[2]), "v"(N1[3])); \
            _Pragma("unroll") for (int e = 4; e < 16; e += 4) { \
                asm volatile("v_max3_f32 %0, %1, %2, %3" : "=v"(ma_) : "v"(ma_), "v"(N0[e]), "v"(N0[e + 1])); \
                asm volatile("v_max3_f32 %0, %1, %2, %3" : "=v"(mb_) : "v"(mb_), "v"(N0[e + 2]), "v"(N0[e + 3])); \
                asm volatile("v_max3_f32 %0, %1, %2, %3" : "=v"(ma_) : "v"(ma_), "v"(N1[e]), "v"(N1[e + 1])); \
                asm volatile("v_max3_f32 %0, %1, %2, %3" : "=v"(mb_) : "v"(mb_), "v"(N1[e + 2]), "v"(N1[e + 3])); } \
            mx = __builtin_fmaxf(ma_, mb_); mx = __builtin_fmaxf(mx, __shfl_xor(mx, 32)); } while (0)
#define AT_PV(s, PF, vbase) do { _Pragma("unroll") for (int d0 = 0; d0 < 4; ++d0) { \
                const s16x4 lo_ = tr4((vbase) + (16 * (s)) * AT_VST + d0 * 64), hi_ = tr4((vbase) + (16 * (s) + 8) * AT_VST + d0 * 64); \
                Oa[d0] = mfma32(cat8(lo_, hi_), PF, Oa[d0]); } } while (0)
#define AT_MIX(npre, nper, niter, nv) do { __builtin_amdgcn_sched_group_barrier(0x100, (npre), 0); \
            _Pragma("unroll") for (int i_ = 0; i_ < 8; ++i_) { __builtin_amdgcn_sched_group_barrier(0x008, 1, 0); \
                if (i_ < (niter)) __builtin_amdgcn_sched_group_barrier(0x100, (nper), 0); \
                __builtin_amdgcn_sched_group_barrier(0x002, (nv), 0); } } while (0)
#define AT_SOFT(P0, P1, t) do { \
            AT_MAX(P0, P1); \
            if (__builtin_amdgcn_ballot_w64(!(__builtin_fabsf(mx) <= 60.f) || mrun != 0.f) != 0ull) { \
                const float mnew_ = ((t) == 0) ? mx : fmaxf(mrun, mx), alpha_ = ((t) == 0) ? 1.f : fexp2(mrun - mnew_); mrun = mnew_; \
                _Pragma("unroll") for (int e = 0; e < 16; ++e) { P0[e] -= mnew_; P1[e] -= mnew_; } \
                lrun *= alpha_; \
                if (__builtin_amdgcn_ballot_w64(alpha_ != 1.f) != 0ull) { \
                    _Pragma("unroll") for (int d0 = 0; d0 < 4; ++d0) _Pragma("unroll") for (int e = 0; e < 16; ++e) Oa[d0][e] *= alpha_; } \
            } \
            float sum_ = 0.f; \
            _Pragma("unroll") for (int e = 0; e < 16; ++e) { P0[e] = fexp2(P0[e]); sum_ += P0[e]; } \
            pf0 = pack8<0>(P0); pf1 = pack8<8>(P0); \
            _Pragma("unroll") for (int e = 0; e < 16; ++e) { P1[e] = fexp2(P1[e]); sum_ += P1[e]; } \
            pf2 = pack8<0>(P1); pf3 = pack8<8>(P1); \
            lrun += sum_; } while (0)
#define AT_PVALL(so) do { cldsp vbase_ = lds + (so) + AT_KBUF + (4 * hh + q4) * AT_VST + (16 * blk + 4 * p4) * 2; \
            AT_PV(0, pf0, vbase_); AT_PV(1, pf1, vbase_); AT_PV(2, pf2, vbase_); AT_PV(3, pf3, vbase_); } while (0)
#define AT_HEAD(S, t) do { __builtin_amdgcn_sched_barrier(0); AT_STORE(S, sW); { const int tn3_ = ((t) + 3 < NT) ? (t) + 3 : NT - 1; AT_LOAD(S, tn3_); } } while (0)
#define AT_TAIL() do { { const int t_ = sVp; sVp = sV; sV = sW; sW = t_; } __syncthreads(); } while (0)
        AT_LOAD(sA, 0); AT_STORE(sA, 0);
        AT_LOAD(sB, 1); AT_LOAD(sA, 2);
        __syncthreads();
        int sVp = 2 * AT_STAGE, sV = 0, sW = AT_STAGE;
        f32x16 c0, c1;
        bf16x8 pf0 = {0, 0, 0, 0, 0, 0, 0, 0}, pf1 = pf0, pf2 = pf0, pf3 = pf0;
#define AT_STEP_A(S, t) do { AT_HEAD(S, t); AT_QK(c0, c1, sV, 0.f); AT_SOFT(c0, c1, t); __builtin_amdgcn_sched_barrier(0); AT_PVALL(sV); AT_TAIL(); } while (0)
#define AT_STEP_B(S, t) do { AT_HEAD(S, t); AT_QK(c0, c1, sV, 0.f); { const int sp_ = ((t) > 0) ? sVp : sV; AT_PVALL(sp_); } __builtin_amdgcn_sched_barrier(0); AT_SOFT(c0, c1, t); AT_TAIL(); } while (0)
        if (sh == 0) {
            for (int t = 0; t < NT; t += 2) { AT_STEP_A(sB, t); AT_STEP_A(sA, t + 1); }
        } else {
            for (int t = 0; t < NT; t += 2) { AT_STEP_B(sB, t); AT_STEP_B(sA, t + 1); }
            AT_PVALL(sVp);
        }
        __syncthreads();
        const float ltot = lrun + __shfl_xor(lrun, 32);
        LAS float* X = (LAS float*)lds + (size_t)(qb * 64) * 64 + lane;
        if (sh == 1) {
            const float sc = lam / ltot;
#pragma unroll
            for (int d0 = 0; d0 < 4; ++d0)
#pragma unroll
                for (int e = 0; e < 16; ++e) X[(d0 * 16 + e) * 64] = Oa[d0][e] * sc;
        }
        __syncthreads();
        if (sh == 0) {
            const float inv0 = 1.f / ltot;
            float ss = 0.f;
#pragma unroll
            for (int d0 = 0; d0 < 4; ++d0)
#pragma unroll
                for (int e = 0; e < 16; ++e) { const float v = Oa[d0][e] * inv0 - X[(d0 * 16 + e) * 64]; Oa[d0][e] = v; ss += v * v; }
            ss += __shfl_xor(ss, 32);
            const float rs = rsqrtf(ss * (1.f / 128.f) + EPS) * (1.f - lam_init);
            bf16* op = O + (size_t)(qrow0 + qb * 32 + r) * D + h * 128;
#pragma unroll
            for (int d0 = 0; d0 < 4; ++d0)
#pragma unroll
                for (int g4 = 0; g4 < 4; ++g4) {
                    const int dv = 32 * d0 + 8 * g4 + 4 * hh;
                    const f32x4 gs = *(const f32x4*)(subln + dv);
                    u32x2 w; w.x = pk2(Oa[d0][4 * g4 + 0] * rs * gs[0], Oa[d0][4 * g4 + 1] * rs * gs[1]);
                    w.y = pk2(Oa[d0][4 * g4 + 2] * rs * gs[2], Oa[d0][4 * g4 + 3] * rs * gs[3]);
                    *(u32x2*)(op + dv) = w;
                }
        }
        __syncthreads();
    }
#undef AT_TROW
#undef AT_LOAD
#undef AT_STORE
#undef AT_QK
#undef AT_PV
#undef AT_MAX
#undef AT_MIX
#undef AT_HEAD
#undef AT_STEP_A
#undef AT_STEP_B
#undef AT_TAIL
#undef AT_SOFT
#undef AT_PVALL
}

constexpr int RB_KST = 528;
constexpr int RB_VST = 80;
constexpr int RB_RST = 528;
constexpr int RB_K = 0, RB_V = 64 * RB_KST, RB_R = RB_V + 64 * RB_VST, RB_BUF = RB_R + 32 * RB_RST;
static_assert(2 * RB_BUF + 8 * 1024 <= LDS_BYTES - 64, "RB LDS");

__device__ __forceinline__ void retn_rb(ldsp lds, const bf16* __restrict__ P, bf16* __restrict__ OF, bf16* __restrict__ OB, const float* decay_logit) {
    int tid = threadIdx.x; asm volatile("" : "+v"(tid));
    const int lane = tid & 63, wid = __builtin_amdgcn_readfirstlane(tid >> 6), r = lane & 31, hh = lane >> 5;
    const int q4 = (lane & 15) >> 2, p4 = lane & 3, blk = (lane >> 4) & 1;
    const int n16 = lane & 15, quad = lane >> 4, tq = wid & 3, dq = wid >> 2;
    const int G_ = gridDim.x, bid_ = blockIdx.x, vb_ = (G_ % 8 == 0) ? (bid_ % 8) * (G_ / 8) + bid_ / 8 : bid_;
    for (int it = vb_; it < 256; it += G_) {
        const int b = it >> 7, h = (it >> 5) & 3, dir = (it >> 4) & 1, sl = it & 15;
        const float dl = decay_logit[dir * 4 + h];
        const float log2g = -log2f(1.f + expf(-dl));
        const float g64 = exp2f(64.f * log2g);
        bf16* Oout = (dir ? OB : OF) + h * 512 + sl * 32 + dq * 16 + n16;
        f32x16 R;
#pragma unroll
        for (int e = 0; e < 16; ++e) R[e] = 0.f;
        u32x4 k0[4], k1[4], v0, v1;
        bf16x8 qa[8], qb[8], qc[8];
        float qd[4];
#pragma unroll
        for (int j = 0; j < 4; ++j) qd[j] = exp2f((float)(tq * 16 + quad * 4 + j + 1) * log2g);
        const float kd = exp2f((float)(63 - (tid >> 2)) * log2g);
#define RB_ROWBASE(c) (((c) < 4) ? ML + b * CTX + (dir ? 3 - (c) : (c)) * 64 : b * SEQ + (dir ? 127 - ((c) - 4) : ((c) - 4)) * 64)
#define RB_IOFF(i) (dir ? 63 - (i) : (i))
        const long kstep_ = dir ? -16L * 4096 : 16L * 4096;
        const bf16* kp_ = P + (size_t)RB_IOFF(tid >> 5) * 4096 + 1024 + h * 256 + (tid & 31) * 8;
        const bf16* vp_ = P + (size_t)RB_IOFF((tid >> 2) & 63) * 4096 + 2048 + h * 512 + sl * 32 + (tid & 3) * 8;
        const bf16* qp_ = P + (size_t)RB_IOFF(tq * 16 + n16) * 4096 + h * 256 + quad * 8;
        bf16* op_ = (dir ? OB : OF) + h * 512 + sl * 32 + dq * 16 + (size_t)RB_IOFF(tq * 16 + ((lane & 31) >> 1)) * 2048 + (lane & 1) * 8;
        LAS bf16* wt_ = (LAS bf16*)(lds + 2 * RB_BUF + wid * 1024);
#define RB_LOADKV(kreg, vreg, c) do { const size_t ro_ = (size_t)RB_ROWBASE(c) * 4096; \
            _Pragma("unroll") for (int k_ = 0; k_ < 4; ++k_) kreg[k_] = *(const u32x4*)(kp_ + ro_ + k_ * kstep_); \
            if (tid < 256) vreg = *(const u32x4*)(vp_ + ro_); } while (0)
#define RB_LOADQ(QF, c) do { const bf16* q_ = qp_ + (size_t)RB_ROWBASE(c) * 4096; \
            _Pragma("unroll") for (int ks = 0; ks < 8; ++ks) QF[ks] = *(const bf16x8*)(q_ + ks * 32); } while (0)
#define RB_STOREKV(kreg, vreg, bo) do { _Pragma("unroll") for (int k_ = 0; k_ < 4; ++k_) { const int cc_ = tid + 512 * k_, i_ = cc_ >> 5, ch_ = cc_ & 31; \
                *(LAS u32x4*)(lds + (bo) + RB_K + i_ * RB_KST + ch_ * 16) = kreg[k_]; } \
            if (tid < 256) { const int i_ = tid >> 2, ch_ = tid & 3; u32x4 w_; \
                w_.x = pk2(bflo(vreg.x) * kd, bfhi(vreg.x) * kd); w_.y = pk2(bflo(vreg.y) * kd, bfhi(vreg.y) * kd); w_.z = pk2(bflo(vreg.z) * kd, bfhi(vreg.z) * kd); w_.w = pk2(bflo(vreg.w) * kd, bfhi(vreg.w) * kd); \
                *(LAS u32x4*)(lds + (bo) + RB_V + i_ * RB_VST + ch_ * 16) = w_; } } while (0)
#define RB_STORER(bo) do { _Pragma("unroll") for (int g4 = 0; g4 < 4; ++g4) { u32x2 w_; w_.x = pk2(R[4 * g4], R[4 * g4 + 1]); w_.y = pk2(R[4 * g4 + 2], R[4 * g4 + 3]); \
                *(LAS u32x2*)(lds + (bo) + RB_R + r * RB_RST + (32 * wid + 8 * g4 + 4 * hh) * 2) = w_; } } while (0)
#define RB_STEP(QF, QL, KS, VS, c, cur, nxt) do { \
            RB_STOREKV(KS, VS, nxt); \
            { const int c3_ = ((c) + 3 < 132) ? (c) + 3 : 131; RB_LOADKV(KS, VS, c3_); } \
            { const int c2_ = ((c) + 2 < 132) ? (c) + 2 : 131; RB_LOADQ(QL, c2_); } \
            { f32x4 acc_ = {0.f, 0.f, 0.f, 0.f}; \
              cldsp rt_ = lds + (cur) + RB_R + (dq * 16 + n16) * RB_RST + quad * 16; \
              _Pragma("unroll") for (int ks = 0; ks < 8; ++ks) acc_ = mfma16(QF[ks], *(const LAS bf16x8*)(rt_ + ks * 64), acc_); \
              _Pragma("unroll") for (int j = 0; j < 4; ++j) wt_[(4 * quad + j) * 24 + n16] = (bf16)(pk2(acc_[j] * qd[j], 0.f) & 0xffffu); \
              const u32x4 ov_ = *(const LAS u32x4*)(wt_ + ((lane & 31) >> 1) * 24 + (lane & 1) * 8); \
              if (lane < 32) *(u32x4*)(op_ + (size_t)RB_ROWBASE(c) * 2048) = ov_; } \
            { _Pragma("unroll") for (int e = 0; e < 16; ++e) R[e] *= g64; \
              cldsp Kb_ = lds + (cur) + RB_K + (8 * hh + q4) * RB_KST + (32 * wid + 16 * blk + 4 * p4) * 2; \
              cldsp Vb_ = lds + (cur) + RB_V + (8 * hh + q4) * RB_VST + (16 * blk + 4 * p4) * 2; \
              _Pragma("unroll") for (int ks = 0; ks < 4; ++ks) { \
                  const s16x4 alo_ = tr4(Kb_ + (16 * ks) * RB_KST), ahi_ = tr4(Kb_ + (16 * ks + 4) * RB_KST); \
                  const s16x4 blo_ = tr4(Vb_ + (16 * ks) * RB_VST), bhi_ = tr4(Vb_ + (16 * ks + 4) * RB_VST); \
                  R = mfma32(cat8(alo_, ahi_), cat8(blo_, bhi_), R); } } \
            RB_STORER(nxt); \
            __syncthreads(); __builtin_amdgcn_sched_barrier(0); } while (0)
        RB_LOADKV(k0, v0, 0); RB_STOREKV(k0, v0, 0); RB_STORER(0);
        RB_LOADKV(k1, v1, 1); RB_LOADKV(k0, v0, 2); RB_LOADQ(qa, 0); RB_LOADQ(qb, 1);
        __syncthreads();
        for (int c = 0; c < 132; c += 6) {
            RB_STEP(qa, qc, k1, v1, c, 0, RB_BUF);
            RB_STEP(qb, qa, k0, v0, c + 1, RB_BUF, 0);
            RB_STEP(qc, qb, k1, v1, c + 2, 0, RB_BUF);
            RB_STEP(qa, qc, k0, v0, c + 3, RB_BUF, 0);
            RB_STEP(qb, qa, k1, v1, c + 4, 0, RB_BUF);
            RB_STEP(qc, qb, k0, v0, c + 5, RB_BUF, 0);
        }
    }
#undef RB_ROWBASE
#undef RB_IOFF
#undef RB_LOADKV
#undef RB_LOADQ
#undef RB_STOREKV
#undef RB_STORER
#undef RB_STEP
}

constexpr int RA_QST = 528, RA_VST = 1040, RA_SST = 144;
constexpr int RA_Q = 0, RA_K = 64 * RA_QST, RA_V = 2 * 64 * RA_QST, RA_S = RA_V + 64 * RA_VST, RA_ST = RA_S + 64 * RA_SST;
static_assert(RA_ST + 64 * 4 * 4 <= LDS_BYTES, "RA LDS");

__device__ __forceinline__ void retn_ra(ldsp lds, const bf16* __restrict__ P, bf16* __restrict__ OF, const bf16* __restrict__ OB, const float* decay_logit) {
    int tid = threadIdx.x; asm volatile("" : "+v"(tid));
    const int lane = tid & 63, wid = __builtin_amdgcn_readfirstlane(tid >> 6), r = lane & 31, hh = lane >> 5;
    const int q4 = (lane & 15) >> 2, p4 = lane & 3, blk = (lane >> 4) & 1;
    for (int u = blockIdx.x; u < 2 * 4 * 132; u += gridDim.x) {
        const int b = u / 528, h = (u / 132) & 3, cc = u % 132;
        const int rowbase = cc < 4 ? ML + b * CTX + cc * 64 : b * SEQ + (cc - 4) * 64;
        const float lgf = -log2f(1.f + expf(-decay_logit[h])), lgb = -log2f(1.f + expf(-decay_logit[4 + h]));
#pragma unroll
        for (int k = 0; k < 4; ++k) {
            const int c = tid + 512 * k, i = c >> 5, ch = c & 31;
            const bf16* g = P + (size_t)(rowbase + i) * 4096 + h * 256 + ch * 8;
            *(LAS u32x4*)(lds + RA_Q + i * RA_QST + ch * 16) = *(const u32x4*)g;
            *(LAS u32x4*)(lds + RA_K + i * RA_QST + ch * 16) = *(const u32x4*)(g + 1024);
        }
#pragma unroll
        for (int k = 0; k < 8; ++k) {
            const int c = tid + 512 * k, i = c >> 6, ch = c & 63;
            *(LAS u32x4*)(lds + RA_V + i * RA_VST + ch * 16) = *(const u32x4*)(P + (size_t)(rowbase + i) * 4096 + 2048 + h * 512 + ch * 8);
        }
        __syncthreads();
        if (wid < 4) {
            const int kj = wid >> 1, qi = wid & 1;
            f32x16 s;
#pragma unroll
            for (int e = 0; e < 16; ++e) s[e] = 0.f;
#pragma unroll
            for (int ks = 0; ks < 16; ++ks) {
                const bf16x8 a = *(const LAS bf16x8*)(lds + RA_K + (kj * 32 + r) * RA_QST + (ks * 16 + hh * 8) * 2);
                const bf16x8 bb = *(const LAS bf16x8*)(lds + RA_Q + (qi * 32 + r) * RA_QST + (ks * 16 + hh * 8) * 2);
                s = mfma32(a, bb, s);
            }
            const int q = qi * 32 + r;
#pragma unroll
            for (int g4 = 0; g4 < 4; ++g4) {
                float v[4];
#pragma unroll
                for (int e = 0; e < 4; ++e) {
                    const int k = kj * 32 + 8 * g4 + 4 * hh + e, df = q - k;
                    float dcy = 0.f;
                    if (df >= 0) dcy += exp2f((float)df * lgf);
                    if (df <= 0) dcy += exp2f((float)(-df) * lgb);
                    v[e] = s[4 * g4 + e] * dcy;
                }
                u32x2 w; w.x = pk2(v[0], v[1]); w.y = pk2(v[2], v[3]);
                *(LAS u32x2*)(lds + RA_S + q * RA_SST + (kj * 32 + 8 * g4 + 4 * hh) * 2) = w;
            }
        }
        __syncthreads();
        u32x4 fa[4], fb[4];
#define RA_TLOAD(k0) do { _Pragma("unroll") for (int k = 0; k < 4; ++k) { const int c = tid + 512 * ((k0) + k), i = c >> 6, ch = c & 63; \
                const size_t o_ = (size_t)(rowbase + i) * 2048 + h * 512 + ch * 8; fa[k] = *(const u32x4*)(OF + o_); fb[k] = *(const u32x4*)(OB + o_); } } while (0)
#define RA_ADD2(x, y) pk2(bflo(x) + bflo(y), bfhi(x) + bfhi(y))
#define RA_TSTORE(k0) do { _Pragma("unroll") for (int k = 0; k < 4; ++k) { const int c = tid + 512 * ((k0) + k), i = c >> 6, ch = c & 63; u32x4 w_; \
                w_.x = RA_ADD2(fa[k].x, fb[k].x); w_.y = RA_ADD2(fa[k].y, fb[k].y); w_.z = RA_ADD2(fa[k].z, fb[k].z); w_.w = RA_ADD2(fa[k].w, fb[k].w); \
                *(LAS u32x4*)(lds + i * RA_VST + ch * 16) = w_; } } while (0)
        RA_TLOAD(0);
        const int qi = wid & 1, dvr = (wid >> 1) * 128;
        f32x16 acc[4];
#pragma unroll
        for (int db = 0; db < 4; ++db)
#pragma unroll
            for (int e = 0; e < 16; ++e) acc[db][e] = 0.f;
        {
            cldsp Vb = lds + RA_V + (8 * hh + q4) * RA_VST + (dvr + 16 * blk + 4 * p4) * 2;
#pragma unroll
            for (int ks = 0; ks < 4; ++ks) {
                const bf16x8 a = *(const LAS bf16x8*)(lds + RA_S + (qi * 32 + r) * RA_SST + (ks * 16 + hh * 8) * 2);
#pragma unroll
                for (int db = 0; db < 4; ++db) {
                    const s16x4 lo = tr4(Vb + (16 * ks) * RA_VST + db * 64), hi = tr4(Vb + (16 * ks + 4) * RA_VST + db * 64);
                    acc[db] = mfma32(a, cat8(lo, hi), acc[db]);
                }
            }
        }
        RA_TSTORE(0); RA_TLOAD(4); RA_TSTORE(4);
        __syncthreads();
        float ssq[16];
#pragma unroll
        for (int e = 0; e < 16; ++e) {
            const LAS bf16* tp = (const LAS bf16*)(lds + (qi * 32 + crow(e, hh)) * RA_VST) + dvr + r;
            float s2 = 0.f;
#pragma unroll
            for (int db = 0; db < 4; ++db) { const float v = acc[db][e] + __uint_as_float((unsigned)tp[db * 32] << 16); acc[db][e] = v; s2 += v * v; }
            s2 += __shfl_xor(s2, 1); s2 += __shfl_xor(s2, 2); s2 += __shfl_xor(s2, 4); s2 += __shfl_xor(s2, 8); s2 += __shfl_xor(s2, 16);
            ssq[e] = s2;
        }
        LAS float* st = (LAS float*)(lds + RA_ST);
        if (r == 0) {
#pragma unroll
            for (int e = 0; e < 16; ++e) st[(qi * 32 + crow(e, hh)) * 4 + (wid >> 1)] = ssq[e];
        }
        __syncthreads();
#pragma unroll
        for (int e = 0; e < 16; ++e) {
            const int q = qi * 32 + crow(e, hh);
            const f32x4 sv = *(const LAS f32x4*)(st + q * 4);
            const float rs = rsqrtf((sv[0] + sv[1] + sv[2] + sv[3]) * (1.f / 512.f) + EPS);
            LAS bf16* tp = (LAS bf16*)(lds + q * RA_VST) + dvr + r;
#pragma unroll
            for (int db = 0; db < 4; ++db) tp[db * 32] = (bf16)(pk2(acc[db][e] * rs, 0.f) & 0xffffu);
        }
        __syncthreads();
#pragma unroll
        for (int k = 0; k < 8; ++k) { const int c = tid + 512 * k, i = c >> 6, ch = c & 63;
            *(u32x4*)(OF + (size_t)(rowbase + i) * 2048 + h * 512 + ch * 8) = *(const LAS u32x4*)(lds + i * RA_VST + ch * 16); }
#undef RA_TLOAD
#undef RA_ADD2
#undef RA_TSTORE
        __syncthreads();
    }
}

__device__ __forceinline__ int s5_row0(int cidx) { const int b = cidx / 264, cl = cidx % 264; return cl < 8 ? ML + b * CTX + cl * 32 : b * SEQ + (cl - 8) * 32; }

__device__ __forceinline__ void s5_tables(const Params& p, ldsp lds, int tid) {
    LAS float* E = (LAS float*)lds;
    LAS float* BB = E + 33 * 128;
    LAS float* CC = BB + 2048;
    bf16* Mt = (bf16*)(p.ws + WS_P + P_S5_M); bf16* Wt = (bf16*)(p.ws + WS_P + P_S5_W); bf16* Zt = (bf16*)(p.ws + WS_P + P_S5_Z);
    float* A32 = (float*)(p.ws + WS_A32);
    for (int u = blockIdx.x; u < 128; u += gridDim.x) {
        const int g = u >> 1, dir = u & 1, dg = dir * 64 + g;
        const float dt = expf(p.in[I_SLOGDT][dg]);
        for (int i = tid; i < 33 * 64; i += NTHREADS) {
            const int k = i >> 6, pp = i & 63;
            const float lr = p.in[I_SLRE][dg * 64 + pp], li = p.in[I_SLIM][dg * 64 + pp];
            const float mag = expf((float)k * (lr * dt)); float s, c; sincos_cw((float)k * (li * dt), s, c);
            E[i * 2] = mag * c; E[i * 2 + 1] = mag * s;
        }
        for (int i = tid; i < 1024; i += NTHREADS) {
            const int pp = i >> 4;
            const float lr = p.in[I_SLRE][dg * 64 + pp], li = p.in[I_SLIM][dg * 64 + pp];
            const float mag = expf(lr * dt); float s, c; sincos_cw(li * dt, s, c);
            const float nr = mag * c - 1.f, ni = mag * s, den = 1.f / (lr * lr + li * li);
            const float fr = (nr * lr + ni * li) * den, fi = (ni * lr - nr * li) * den;
            const float br = p.in[I_SBRE][(size_t)dg * 1024 + i], bi = p.in[I_SBIM][(size_t)dg * 1024 + i];
            BB[i * 2] = fr * br - fi * bi; BB[i * 2 + 1] = fr * bi + fi * br;
            CC[i * 2] = p.in[I_SCRE][(size_t)dg * 1024 + i]; CC[i * 2 + 1] = p.in[I_SCIM][(size_t)dg * 1024 + i];
        }
        __syncthreads();
        if (tid < 64) { A32[(size_t)(g * 2 + dir) * 128 + tid * 2] = E[(32 * 64 + tid) * 2]; A32[(size_t)(g * 2 + dir) * 128 + tid * 2 + 1] = E[(32 * 64 + tid) * 2 + 1]; }
        const size_t tb = (size_t)(g * 2 + dir);
        for (int i = tid; i < 33 * 256; i += NTHREADS) {
            const int k1 = i >> 8, ci = (i >> 4) & 15, bj = i & 15;
            float acc = 0.f;
            if (k1 > 0) {
                const int k = k1 - 1;
                for (int pp = 0; pp < 64; ++pp) {
                    const float er = E[(k * 64 + pp) * 2], ei = E[(k * 64 + pp) * 2 + 1], cr = CC[(ci * 64 + pp) * 2], cim = CC[(ci * 64 + pp) * 2 + 1];
                    const float xr = cr * er - cim * ei, xi = cr * ei + cim * er;
                    acc += xr * BB[(pp * 16 + bj) * 2] - xi * BB[(pp * 16 + bj) * 2 + 1];
                }
            }
            Mt[tb * (33 * 256) + i] = (bf16)(pk2(acc, 0.f) & 0xffffu);
        }
        for (int i = tid; i < 64 * 512; i += NTHREADS) {
            const int pp = i >> 9, col = i & 511, s = col >> 4, j = col & 15, kk = dir ? s : 31 - s;
            const float er = E[(kk * 64 + pp) * 2], ei = E[(kk * 64 + pp) * 2 + 1], br = BB[(pp * 16 + j) * 2], bi = BB[(pp * 16 + j) * 2 + 1];
            Wt[tb * 65536 + (size_t)(2 * pp) * 512 + col] = (bf16)(pk2(er * br - ei * bi, 0.f) & 0xffffu);
            Wt[tb * 65536 + (size_t)(2 * pp + 1) * 512 + col] = (bf16)(pk2(er * bi + ei * br, 0.f) & 0xffffu);
        }
        for (int i = tid; i < 512 * 64; i += NTHREADS) {
            const int row = i >> 6, pp = i & 63, t = row >> 4, ci = row & 15, e = dir ? 32 - t : t + 1;
            const float er = E[(e * 64 + pp) * 2], ei = E[(e * 64 + pp) * 2 + 1], cr = CC[(ci * 64 + pp) * 2], cim = CC[(ci * 64 + pp) * 2 + 1];
            *(unsigned*)(Zt + tb * 65536 + (size_t)row * 128 + 2 * pp) = pk2(cr * er - cim * ei, -(cr * ei + cim * er));
        }
        __syncthreads();
    }
}

__device__ __forceinline__ void s5_x(const Params& p, int tid) {
    asm volatile("" : "+v"(tid));
    const int lane = tid & 63, wid = __builtin_amdgcn_readfirstlane(tid >> 6), n = lane & 15, quad = lane >> 4;
    const bf16* U = (const bf16*)(p.ws + WS_UY); const bf16* Wt = (const bf16*)(p.ws + WS_P + P_S5_W); float* X = (float*)(p.ws + WS_P + P_S5_X);
    const int G_ = gridDim.x, bid_ = blockIdx.x, vb_ = (G_ % 8 == 0) ? (bid_ % 8) * (G_ / 8) + bid_ / 8 : bid_;
    for (int u = vb_; u < 64 * 33; u += G_) {
        const int ct = u >> 6, g = u & 63, cidx = ct * 16 + n, row0 = s5_row0(cidx);
        bf16x8 uf[16];
#pragma unroll
        for (int ks = 0; ks < 16; ++ks) uf[ks] = *(const bf16x8*)(U + (size_t)(row0 + 2 * ks + (quad >> 1)) * D + g * 16 + 8 * (quad & 1));
#pragma unroll
        for (int dir = 0; dir < 2; ++dir) {
            const bf16* wp = Wt + (size_t)(g * 2 + dir) * 65536 + (size_t)(16 * wid + n) * 512 + 8 * quad;
            f32x4 acc = {0.f, 0.f, 0.f, 0.f};
#pragma unroll
            for (int ks = 0; ks < 16; ++ks) acc = mfma16(*(const bf16x8*)(wp + ks * 32), uf[ks], acc);
            *(f32x4*)(X + ((size_t)(g * 2 + dir) * 528 + cidx) * 128 + 16 * wid + 4 * quad) = acc;
        }
    }
}
__device__ __forceinline__ void s5_scan(const Params& p, int gtid) {
    if (gtid >= 131072) return;
    const int seg = gtid & 7, pp = (gtid >> 3) & 63, dir = (gtid >> 9) & 1, g = (gtid >> 10) & 63, b = gtid >> 16;
    const float* X = (const float*)(p.ws + WS_P + P_S5_X) + (size_t)(g * 2 + dir) * 528 * 128 + 2 * pp;
    bf16* Hs = (bf16*)(p.ws + WS_P + P_S5_H) + (size_t)(g * 2 + dir) * 528 * 128 + 2 * pp;
    const float* A32 = (const float*)(p.ws + WS_A32) + (size_t)(g * 2 + dir) * 128 + 2 * pp;
    const float ar = A32[0], ai = A32[1];
    f32x2 xv[33];
#pragma unroll
    for (int k = 0; k < 33; ++k) {
        const int st = seg * 33 + k;
        const int cl = dir ? (st < 8 ? 7 - st : 263 - (st - 8)) : st;
        xv[k] = *(const f32x2*)(X + (size_t)(b * 264 + cl) * 128);
    }
    float er = 0.f, ei = 0.f, pr = 1.f, pi = 0.f;
#pragma unroll
    for (int k = 0; k < 33; ++k) {
        const float nr = ar * er - ai * ei + xv[k][0], ni = ar * ei + ai * er + xv[k][1]; er = nr; ei = ni;
        const float qr = ar * pr - ai * pi, qi = ar * pi + ai * pr; pr = qr; pi = qi;
    }
    float hr = 0.f, hi = 0.f;
    const int lane = threadIdx.x & 63, lbase = lane & ~7;
#pragma unroll
    for (int j = 0; j < 7; ++j) {
        const float tr_ = __shfl(er, lbase + j), ti_ = __shfl(ei, lbase + j);
        if (j < seg) { const float nr = pr * hr - pi * hi + tr_, ni = pr * hi + pi * hr + ti_; hr = nr; hi = ni; }
    }
#pragma unroll
    for (int k = 0; k < 33; ++k) {
        const int st = seg * 33 + k;
        const int cl = dir ? (st < 8 ? 7 - st : 263 - (st - 8)) : st;
        *(unsigned*)(Hs + (size_t)(b * 264 + cl) * 128) = pk2(hr, hi);
        const float nr = ar * hr - ai * hi + xv[k][0], ni = ar * hi + ai * hr + xv[k][1]; hr = nr; hi = ni;
    }
}
__device__ __forceinline__ void s5_y(const Params& p, ldsp lds, int tid) {
    asm volatile("" : "+v"(tid));
    const int lane = tid & 63, wid = __builtin_amdgcn_readfirstlane(tid >> 6), n = lane & 15, quad = lane >> 4;
    const bf16* U = (const bf16*)(p.ws + WS_UY); const bf16* Mt = (const bf16*)(p.ws + WS_P + P_S5_M); const bf16* Zt = (const bf16*)(p.ws + WS_P + P_S5_Z);
    const bf16* Hs = (const bf16*)(p.ws + WS_P + P_S5_H); bf16* Og = (bf16*)(p.ws + WS_P + P_S5_O);
    const float* dsk = p.in[I_SD];
    for (int i = tid; i < 2 * 1024; i += NTHREADS) *(LAS u32x4*)(lds + (i >> 10) * 32768 + (i & 1023) * 16) = (u32x4){0u, 0u, 0u, 0u};
    const int G_ = gridDim.x, bid_ = blockIdx.x, vb_ = (G_ % 8 == 0) ? (bid_ % 8) * (G_ / 8) + bid_ / 8 : bid_;
    for (int u = vb_; u < 64 * 33; u += G_) {
        const int ct = u >> 6, g = u & 63, cidx = ct * 16 + n, row0 = s5_row0(cidx);
        __syncthreads();
        for (int i = tid; i < 2 * 1024; i += NTHREADS) { const int dir = i >> 10, c = i & 1023;
            *(LAS u32x4*)(lds + dir * 32768 + 16384 + c * 16) = *(const u32x4*)(Mt + (size_t)(g * 2 + dir) * 8448 + 256 + (size_t)c * 8); }
        bf16x8 uf[16], hf[2][4];
#pragma unroll
        for (int ks = 0; ks < 16; ++ks) uf[ks] = *(const bf16x8*)(U + (size_t)(row0 + 2 * ks + (quad >> 1)) * D + g * 16 + 8 * (quad & 1));
#pragma unroll
        for (int dir = 0; dir < 2; ++dir)
#pragma unroll
            for (int kk = 0; kk < 4; ++kk) hf[dir][kk] = *(const bf16x8*)(Hs + ((size_t)(g * 2 + dir) * 528 + cidx) * 128 + kk * 32 + 8 * quad);
        __syncthreads();
        for (int tt = 0; tt < 4; ++tt) {
            const int t = wid * 4 + tt;
            f32x4 acc = {0.f, 0.f, 0.f, 0.f};
            cldsp mf = lds + (t + 32 - (quad >> 1)) * 512 + n * 32 + (quad & 1) * 16;
            cldsp mb = lds + 32768 + (32 - t + (quad >> 1)) * 512 + n * 32 + (quad & 1) * 16;
#pragma unroll
            for (int ks = 0; ks < 16; ++ks) {
                if (2 * ks <= t) acc = mfma16(*(const LAS bf16x8*)(mf - ks * 1024), uf[ks], acc);
                if (2 * ks + 1 >= t) acc = mfma16(*(const LAS bf16x8*)(mb + ks * 1024), uf[ks], acc);
            }
#pragma unroll
            for (int dir = 0; dir < 2; ++dir)
#pragma unroll
                for (int kk = 0; kk < 4; ++kk)
                    acc = mfma16(*(const bf16x8*)(Zt + (size_t)(g * 2 + dir) * 65536 + (size_t)(t * 16 + n) * 128 + kk * 32 + 8 * quad), hf[dir][kk], acc);
            const size_t off = (size_t)(row0 + t) * D + g * 16 + 4 * quad;
            const u32x2 uw = *(const u32x2*)(U + off);
            const f32x4 dv = *(const f32x4*)(dsk + g * 16 + 4 * quad);
            const float y0 = acc[0] + dv[0] * bflo(uw.x), y1 = acc[1] + dv[1] * bfhi(uw.x), y2 = acc[2] + dv[2] * bflo(uw.y), y3 = acc[3] + dv[3] * bfhi(uw.y);
            u32x2 w; w.x = pk2(gelu_tanh(y0), gelu_tanh(y1)); w.y = pk2(gelu_tanh(y2), gelu_tanh(y3));
            *(u32x2*)(Og + off) = w;
        }
    }
}


#define PHASE_BEGIN if (ph >= p.ph_lo && ph < p.ph_hi) {
#define PHASE_END   if (ph + 1 < p.ph_hi) { if (ph == 0) grid.sync(); else xcd_barrier(bar); } } ++ph;
#define PHASE_END_F(nosync) if (!(nosync) && ph + 1 < p.ph_hi) { xcd_barrier(bar); } } ++ph;
template <int L> __device__ __forceinline__ void layer_body(const Params& p, cg::grid_group& grid, const XcdBarrier& bar, ldsp lds, int& ph) {
    const int tid = threadIdx.x, lane = tid & 63, wave = __builtin_amdgcn_readfirstlane(tid >> 6);
    const int G = gridDim.x;
    const int gw = blockIdx.x * 8 + wave, ngw = G * 8;
    const int gtid = blockIdx.x * NTHREADS + tid;
    bf16* Wb = (bf16*)(p.ws + WS_W);
    bf16* UY = (bf16*)(p.ws + WS_UY);
    unsigned char* Pr = p.ws + WS_P;
    const float* normg = p.in[I_NORMG];
    (void)gtid; (void)lane;

        constexpr int l = L; constexpr int kind = L % 3, j = L / 3;
        constexpr bool last = (L == 3);
        constexpr int Mrows = last ? ML : MT;
        if constexpr (kind == 0) {
            PHASE_BEGIN
                EpiAttnIn E{(bf16*)Pr, (const float*)(p.ws + WS_ROPEA)};
                run_gemm(lds, UY, Wb + W_IN, MT, 3072, D, E);
            PHASE_END
            PHASE_BEGIN
                attn_phase(lds, (const bf16*)Pr, (bf16*)(Pr + P_ATT_O), p.in[I_ALAM] + j * 256, p.in[I_ASUBLN] + j * 128, 0.8f - 0.6f * expf(-0.3f * (float)l), !last);
            PHASE_END
            PHASE_BEGIN
                EpiStore E{UY, D};
                run_gemm(lds, (const bf16*)(Pr + P_ATT_O), Wb + W_OUT, ML, D, D, E);
                if (!last) ctx_gemm<1024>(lds, (const bf16*)(Pr + P_ATT_O), Wb + W_OUT, UY);
            PHASE_END
        } else if constexpr (kind == 1) {
            PHASE_BEGIN
                EpiRetIn E{(bf16*)Pr, (const float*)(p.ws + WS_ROPER)};
                run_gemm(lds, UY, Wb + W_IN, MT, 4096, D, E);
            PHASE_END
            PHASE_BEGIN
                retn_rb(lds, (const bf16*)Pr, (bf16*)(Pr + P_RET_OF), (bf16*)(Pr + P_RET_OB), p.in[I_RDECAY]);
            PHASE_END
            PHASE_BEGIN
                retn_ra(lds, (const bf16*)Pr, (bf16*)(Pr + P_RET_OF), (const bf16*)(Pr + P_RET_OB), p.in[I_RDECAY]);
            PHASE_END
            PHASE_BEGIN
                EpiRetGate E{(bf16*)(Pr + P_RET_OF), 2048};
                run_gemm(lds, UY, Wb + W_G, MT, 2048, D, E);
            PHASE_END
            PHASE_BEGIN
                EpiStore E{UY, D};
                run_gemm(lds, (const bf16*)(Pr + P_RET_OF), Wb + W_OUT, ML, D, 2048, E);
                if (!last) ctx_gemm<2048>(lds, (const bf16*)(Pr + P_RET_OF), Wb + W_OUT, UY);
            PHASE_END
        } else {
            PHASE_BEGIN
                s5_x(p, tid);
            PHASE_END
            PHASE_BEGIN
                s5_scan(p, gtid);
                conv_layer(p, 2, lds, gw, ngw, lane, wave);
            PHASE_END
            PHASE_BEGIN
                s5_y(p, lds, tid);
            PHASE_END
            PHASE_BEGIN
                EpiPair<1> E{UY, D};
                run_gemm(lds, (const bf16*)(Pr + P_S5_O), Wb + W_OUT, Mrows, 2048, D, E);
            PHASE_END
        }
        PHASE_BEGIN
            rows_phase(p, 1, Mrows, normg + l * 4096 + 1 * 1024, l, 2, true, normg + l * 4096 + 2 * 1024, l, 3, gw, ngw, lane);
        PHASE_END
        PHASE_BEGIN
            EpiPair<0> E{(bf16*)Pr, FF};
            run_gemm(lds, UY, Wb + W_GU, Mrows, 2 * FF, D, E);
        PHASE_END
        PHASE_BEGIN
            EpiStore E{UY, D};
            run_gemm(lds, (const bf16*)Pr, Wb + W_DN, ML, D, FF, E);
            if (!last) ctx_gemm<FF>(lds, (const bf16*)Pr, Wb + W_DN, UY);
        PHASE_END
        PHASE_BEGIN
            rows_phase(p, 1, Mrows, normg + l * 4096 + 3 * 1024, l, 5, !last, normg + (last ? 0 : (l + 1) * 4096), last ? 0 : l + 1, 0, gw, ngw, lane, last);
            if (!last) {
                __syncthreads();
                if (l != 1) conv_layer(p, l + 1, lds, gw, ngw, lane, wave);
                if (l == 1) { __syncthreads(); s5_tables(p, lds, tid); }
            }
        PHASE_END_F(last)
    }
__global__ void __launch_bounds__(NTHREADS, 2) fwd_megakernel(Params p) {
    extern __shared__ __attribute__((aligned(16))) unsigned char lds_raw[];
    cg::grid_group grid = cg::this_grid();
    ldsp lds = (ldsp)lds_raw;
    const int tid = threadIdx.x, lane = tid & 63, wave = __builtin_amdgcn_readfirstlane(tid >> 6);
    const int G = gridDim.x;
    const int gw = blockIdx.x * 8 + wave, ngw = G * 8;
    const int gtid = blockIdx.x * NTHREADS + tid, ngt = G * NTHREADS;
    bf16* Wb = (bf16*)(p.ws + WS_W);
    bf16* UY = (bf16*)(p.ws + WS_UY);
    unsigned char* Pr = p.ws + WS_P;
    const float* normg = p.in[I_NORMG];
    int ph = 0;
    if (tid < 16) ((LAS unsigned*)(lds + LDS_BYTES - 64))[tid] = 0u;
    __syncthreads();
    const XcdBarrier bar = xcd_barrier_post((unsigned*)(p.ws + WS_BAR), (volatile LAS unsigned*)(lds + LDS_BYTES - 64));

    PHASE_BEGIN
        mods_phase(p, lds, tid);
        rope_tables(p, gtid, ngt);
        __syncthreads();
        conv_layer(p, 0, lds, gw, ngw, lane, wave);
    PHASE_END
    PHASE_BEGIN
        rows_phase(p, 0, MT, nullptr, 0, 0, true, normg + 0 * 4096 + 0 * 1024, 0, 0, gw, ngw, lane);
    PHASE_END
    layer_body<0>(p, grid, bar, lds, ph);
    layer_body<1>(p, grid, bar, lds, ph);
    layer_body<2>(p, grid, bar, lds, ph);
    layer_body<3>(p, grid, bar, lds, ph);
#undef PHASE_BEGIN
#undef PHASE_END
#undef PHASE_END_F
}

extern "C" void kernel_launch(void* const* d_in, const int* in_sizes, int n_in, void* d_out, int out_size, void* d_ws, size_t ws_size, hipStream_t stream) {
    static int grid_blocks = 0;
    if (grid_blocks == 0) {
        if (n_in != 26 || out_size != ML * D || ws_size < WS_END) { fprintf(stderr, "kernel_launch: unexpected shapes (n_in %d out %d ws %zu need %zu)\n", n_in, out_size, ws_size, (size_t)WS_END); grid_blocks = -1; return; }
        int dev = 0, cus = 0, per_cu = 0;
        hipGetDevice(&dev);
        hipDeviceGetAttribute(&cus, hipDeviceAttributeMultiprocessorCount, dev);
        hipFuncSetAttribute((const void*)fwd_megakernel, hipFuncAttributeMaxDynamicSharedMemorySize, LDS_BYTES);
        hipOccupancyMaxActiveBlocksPerMultiprocessor(&per_cu, (const void*)fwd_megakernel, NTHREADS, LDS_BYTES);
        if (per_cu < 1) { fprintf(stderr, "kernel_launch: occupancy query returned %d\n", per_cu); per_cu = 1; }
        (void)hipGetLastError();
        grid_blocks = cus;
    }
    if (grid_blocks < 0) return;
    Params p{};
    for (int i = 0; i < 26; ++i) p.in[i] = (const float*)d_in[i];
    p.out = (float*)d_out; p.ws = (unsigned char*)d_ws; p.ph_lo = 0; p.ph_hi = 1000;
    if (hipMemsetAsync((char*)d_ws + WS_BAR, 0, 16384, stream) != hipSuccess) { fprintf(stderr, "kernel_launch: memset failed\n"); return; }
    void* args[] = {&p};
    hipError_t e = hipLaunchCooperativeKernel((const void*)fwd_megakernel, dim3(grid_blocks), dim3(NTHREADS), args, LDS_BYTES, stream);
    if (e != hipSuccess) fprintf(stderr, "cooperative launch failed: %s (grid %d)\n", hipGetErrorString(e), grid_blocks);
}
```

```cpp
#include <hip/hip_runtime.h>
#include <hip/hip_cooperative_groups.h>
#include <cstdint>
#include <cstdio>
namespace cg = cooperative_groups;

typedef unsigned short bf16;
typedef short bf16x8 __attribute__((ext_vector_type(8)));
typedef short s16x4 __attribute__((ext_vector_type(4)));
typedef float f32x2 __attribute__((ext_vector_type(2)));
typedef float f32x4 __attribute__((ext_vector_type(4)));
typedef float f32x16 __attribute__((ext_vector_type(16)));
typedef unsigned u32x2 __attribute__((ext_vector_type(2)));
typedef unsigned u32x4 __attribute__((ext_vector_type(4)));
typedef __bf16 bf16x2_t __attribute__((ext_vector_type(2)));
#define LAS __attribute__((address_space(3)))
typedef LAS unsigned char* ldsp;
typedef const LAS unsigned char* cldsp;

constexpr int D = 1024, SEQ = 8192, CTX = 256, ML = 16384, MT = 16896, FF = 2816;
constexpr float EPS = 1e-6f;
constexpr float LOG2E = 1.4426950408889634f;

constexpr size_t MiB = 1u << 20;
constexpr size_t WS_MOD = 0;
constexpr size_t WS_ROPEA = 512 * 1024;
constexpr size_t WS_ROPER = WS_ROPEA + 64 * 1024;
constexpr size_t WS_A32 = WS_ROPER + 128 * 1024;
constexpr size_t WS_BAR = 800 * 1024;
constexpr size_t WS_HC = 1 * MiB;
constexpr size_t WS_W = 4 * MiB;
constexpr size_t WS_UY = 40 * MiB;
constexpr size_t WS_P = 76 * MiB;
constexpr size_t WS_HB = WS_P + 264 * MiB;
constexpr size_t WS_END = WS_HB + 34 * MiB;
constexpr size_t W_IN = 0, W_G = 4096 * 1024, W_OUT = 6144 * 1024, W_GU = 8192 * 1024 + 1024 * 1024, W_DN = W_GU + 5632 * 1024;
constexpr size_t P_ATT_O = 100 * MiB;
constexpr size_t P_RET_OF = 132 * MiB, P_RET_OB = 198 * MiB;
constexpr size_t P_S5_O = 0;
constexpr size_t P_S5_M = 100 * MiB;
constexpr size_t P_S5_W = 104 * MiB;
constexpr size_t P_S5_Z = 120 * MiB;
constexpr size_t P_S5_X = 136 * MiB;
constexpr size_t P_S5_H = 170 * MiB;

constexpr int NTHREADS = 512;
constexpr int LDS_BYTES = 160 * 1024;

__device__ __forceinline__ unsigned pk2(float lo, float hi) { f32x2 v = {lo, hi}; bf16x2_t b = __builtin_convertvector(v, bf16x2_t); return __builtin_bit_cast(unsigned, b); }
__device__ __forceinline__ float bflo(unsigned w) { return __uint_as_float(w << 16); }
__device__ __forceinline__ float bfhi(unsigned w) { return __uint_as_float(w & 0xffff0000u); }
__device__ __forceinline__ float wave_sum(float v) {
#pragma unroll
    for (int o = 1; o < 64; o <<= 1) v += __shfl_xor(v, o);
    return v;
}
__device__ __forceinline__ float fexp2(float x) { return __builtin_amdgcn_exp2f(x); }
__device__ __forceinline__ float siluf(float x) { return x / (1.f + fexp2(-x * LOG2E)); }
__device__ __forceinline__ float sigmf(float x) { return 1.f / (1.f + fexp2(-x * LOG2E)); }
__device__ __forceinline__ float gelu_tanh(float x) {
    const float z = 0.7978845608028654f * (x + 0.044715f * x * x * x);
    const float t = fexp2(z * (2.f * LOG2E));
    const float th = 1.f - 2.f / (t + 1.f);
    return 0.5f * x * (1.f + th);
}
__device__ __forceinline__ void sincos_cw(float x, float& s, float& c) {
    const float n = rintf(x * 0.6366197723675814f);
    float r = fmaf(-n, 1.5703125f, x);
    r = fmaf(-n, 4.837512969970703125e-4f, r);
    r = fmaf(-n, 7.54978995489188216e-8f, r);
    const float r2 = r * r;
    const float sp = r + r * r2 * (-1.6666666667e-1f + r2 * (8.3333333333e-3f + r2 * (-1.9841269841e-4f + r2 * 2.7557319224e-6f)));
    const float cp = 1.f + r2 * (-0.5f + r2 * (4.1666666667e-2f + r2 * (-1.3888888889e-3f + r2 * (2.4801587302e-5f + r2 * -2.7557319224e-7f))));
    const int q = ((int)n) & 3;
    s = (q == 0) ? sp : (q == 1) ? cp : (q == 2) ? -sp : -cp;
    c = (q == 0) ? cp : (q == 1) ? -sp : (q == 2) ? -cp : sp;
}
__device__ __forceinline__ f32x16 mfma32(bf16x8 a, bf16x8 b, f32x16 c) { return __builtin_amdgcn_mfma_f32_32x32x16_bf16(a, b, c, 0, 0, 0); }
__device__ __forceinline__ f32x4 mfma16(bf16x8 a, bf16x8 b, f32x4 c) { return __builtin_amdgcn_mfma_f32_16x16x32_bf16(a, b, c, 0, 0, 0); }
typedef short v4i16_t __attribute__((ext_vector_type(4)));
__device__ __forceinline__ s16x4 tr4(cldsp p) { return __builtin_bit_cast(s16x4, __builtin_amdgcn_ds_read_tr16_b64_v4i16((LAS v4i16_t*)p)); }
__device__ __forceinline__ bf16x8 cat8(s16x4 lo, s16x4 hi) { return (bf16x8){lo[0], lo[1], lo[2], lo[3], hi[0], hi[1], hi[2], hi[3]}; }
template <int s8> __device__ __forceinline__ bf16x8 pack8(const f32x16& x) {
    u32x4 p;
    p[0] = pk2(x[s8 + 0], x[s8 + 1]); p[1] = pk2(x[s8 + 2], x[s8 + 3]); p[2] = pk2(x[s8 + 4], x[s8 + 5]); p[3] = pk2(x[s8 + 6], x[s8 + 7]);
    return __builtin_bit_cast(bf16x8, p);
}
__device__ __forceinline__ int crow(int reg, int h) { return (reg & 3) + 8 * (reg >> 2) + 4 * h; }
__device__ __forceinline__ float max3f(float a, float b, float c) { return __builtin_fmaxf(__builtin_fmaxf(a, b), c); }
namespace pg8 {
#define PG8_LAS __attribute__((address_space(3)))
typedef unsigned short bf16_t;
typedef short bf16x8 __attribute__((ext_vector_type(8)));
typedef float f32x4 __attribute__((ext_vector_type(4)));
typedef unsigned u32x4 __attribute__((ext_vector_type(4)));
constexpr int BM = 256, BK = 64, HALF = 128, HTB = HALF * BK * 2  , STAGE_BYTES = 8 * HTB, NXCD = 8, WGM = 8;

__host__ __device__ __forceinline__ int lds_byte(int r, int c) { const int st = (r >> 4) * 2 + (c >> 5), rr = r & 15, cc = c & 31, ob = rr * 64 + cc * 2; return st * 1024 + (ob ^ (((ob >> 9) & 1) << 5)); }
__host__ __device__ __forceinline__ void stage_rc(int b, int& R, int& C) { const int st = b / 1024, sb = b % 1024, swz = sb ^ (((sb >> 9) & 1) << 5); R = (st >> 1) * 16 + swz / 64; C = (st & 1) * 32 + (swz % 64) / 2; }
__host__ __device__ __forceinline__ int perm32(int rho) { const int n = rho >> 4, i = rho & 15; return 8 * (i >> 2) + 4 * n + (i & 3); }

struct Unit { int pm, pn; };
struct Gemm { const bf16_t* A; const bf16_t* Bt; int M, N, K; };

struct StaticOrder {
    int nM, nN, nwg, G, c;
    __host__ __device__ void init(int M, int N, int G_, int c_) { nM = M / BM; nN = N / BM; nwg = nM * nN; G = G_; c = c_; }
    __host__ __device__ bool next(int i, Unit& u) const {
        const long L = (long)i * G + c; if (L >= nwg) return false;
        int wgid = (int)L; { const int q = nwg / NXCD, r = nwg % NXCD, xcd = wgid % NXCD, off = wgid / NXCD; wgid = (xcd < r ? xcd * (q + 1) : r * (q + 1) + (xcd - r) * q) + off; }
        const int nig = WGM * nN, gid = wgid / nig, fm = gid * WGM, gsz = (nM - fm) < WGM ? (nM - fm) : WGM;
        u.pm = fm + ((wgid % nig) % gsz); u.pn = (wgid % nig) / gsz; return true;
    }
    __device__ __forceinline__ void a_ready(const Unit&) const {}
    __device__ __forceinline__ void done(const Unit&) const {}
};
__device__ __forceinline__ unsigned cvt_pk_bf16(float lo, float hi) { unsigned r; asm volatile("v_cvt_pk_bf16_f32 %0, %1, %2" : "=v"(r) : "v"(lo), "v"(hi)); return r; }
template <class Epi, class Sched, bool ALIGN_EPI = false, bool SP2 = false>
__device__ __forceinline__ void gemm_phase(PG8_LAS unsigned char* lds, const Gemm g, const Sched& S, const Epi& E) {
    int tid = threadIdx.x; asm volatile("" : "+v"(tid));
    const int wid = __builtin_amdgcn_readfirstlane(tid >> 6), lane = tid & 63, wr = wid >> 2, wc = wid & 3, fr = lane & 15, fq = lane >> 4;
    const int K = g.K, nt = K / BK;
    unsigned voffA[2], voffB[2];
#pragma unroll
    for (int i = 0; i < 2; ++i) { int R, C; stage_rc(tid * 16 + i * 8192, R, C); const int Rb = Epi::PERM ? ((R & ~31) + perm32(R & 31)) : R;
        voffA[i] = (unsigned)(R * K + C) * 2u; voffB[i] = (unsigned)(Rb * K + C) * 2u; }
    const size_t kstep = (size_t)(BK * 2);
    const size_t hstep = (size_t)HALF * K * 2;
    const size_t tstep = 2 * hstep;
    const unsigned ldsw = (unsigned)wid * 1024u;
    const int aoff = lds_byte(wr * 64 + fr, fq * 8), boff = lds_byte(wc * 32 + fr, fq * 8);
#define PG8_SA(b, h) (((b) * 2 + (h)) * HTB)
#define PG8_SB(b, h) ((4 + (b) * 2 + (h)) * HTB)
#define PG8_STAGE(bufoff, gbase, voff) do { _Pragma("unroll") for (int _i = 0; _i < 2; ++_i) \
        __builtin_amdgcn_global_load_lds((const unsigned*)((const char*)(gbase) + (voff)[_i]), (PG8_LAS unsigned*)(lds + (bufoff) + ldsw + _i * 8192), 16, 0, 0); } while (0)
#define PG8_LDA(dst, b, h) do { _Pragma("unroll") for (int m = 0; m < 4; ++m) _Pragma("unroll") for (int k = 0; k < 2; ++k) dst[m][k] = *(const PG8_LAS bf16x8*)(lds + PG8_SA(b, h) + aoff + m * 2048 + k * 1024); } while (0)
#define PG8_LDB(dst, b, h) do { _Pragma("unroll") for (int n = 0; n < 2; ++n) _Pragma("unroll") for (int k = 0; k < 2; ++k) dst[n][k] = *(const PG8_LAS bf16x8*)(lds + PG8_SB(b, h) + boff + n * 2048 + k * 1024); } while (0)
#define PG8_MMA(ai, bj, At, Bt) do { __builtin_amdgcn_s_setprio(1); _Pragma("unroll") for (int m = 0; m < 4; ++m) _Pragma("unroll") for (int n = 0; n < 2; ++n) _Pragma("unroll") for (int k = 0; k < 2; ++k) \
        acc[ai][bj][m][n] = __builtin_amdgcn_mfma_f32_16x16x32_bf16(Bt[n][k], At[m][k], acc[ai][bj][m][n], 0, 0, 0); __builtin_amdgcn_s_setprio(0); } while (0)
#define PG8_WAIT_V(n) asm volatile("s_waitcnt vmcnt(" #n ")" ::: "memory")
#define PG8_WAIT_L(n) asm volatile("s_waitcnt lgkmcnt(" #n ")" ::: "memory")
#define PG8_BAR __builtin_amdgcn_s_barrier()
#define PG8_SCHED __builtin_amdgcn_sched_barrier(0)
    Unit cur, nxt; int ui = 0;
    if (!S.next(0, cur)) return;
    f32x4 acc[2][2][4][2];
#pragma unroll
    for (int a = 0; a < 2; ++a)
#pragma unroll
        for (int b = 0; b < 2; ++b)
#pragma unroll
            for (int m = 0; m < 4; ++m)
#pragma unroll
                for (int n = 0; n < 2; ++n) acc[a][b][m][n] = (f32x4){0.f, 0.f, 0.f, 0.f};
    bf16x8 At[4][2], B0[2][2], B1[2][2];
    const char* cA = (const char*)g.A + (size_t)cur.pm * tstep; const char* cB = (const char*)g.Bt + (size_t)cur.pn * tstep;
    S.a_ready(cur);
    if constexpr (SP2) {
        PG8_STAGE(PG8_SB(0, 0), cB, voffB); PG8_STAGE(PG8_SB(0, 1), cB + hstep, voffB); PG8_STAGE(PG8_SA(0, 0), cA, voffA); PG8_STAGE(PG8_SA(0, 1), cA + hstep, voffA);
        if (wr == 1) PG8_BAR;
        PG8_WAIT_V(2); PG8_BAR;
        PG8_STAGE(PG8_SB(1, 0), cB + kstep, voffB); PG8_STAGE(PG8_SA(1, 0), cA + kstep, voffA); PG8_STAGE(PG8_SB(1, 1), cB + hstep + kstep, voffB);
        PG8_WAIT_V(6); PG8_BAR;
    } else {
        PG8_STAGE(PG8_SB(0, 0), cB, voffB); PG8_STAGE(PG8_SA(0, 0), cA, voffA); PG8_STAGE(PG8_SB(0, 1), cB + hstep, voffB); PG8_STAGE(PG8_SA(0, 1), cA + hstep, voffA);
        if (wr == 1) PG8_BAR;
        PG8_WAIT_V(4); PG8_BAR;
        PG8_STAGE(PG8_SB(1, 0), cB + kstep, voffB); PG8_STAGE(PG8_SA(1, 0), cA + kstep, voffA); PG8_STAGE(PG8_SB(1, 1), cB + hstep + kstep, voffB);
        PG8_WAIT_V(6); PG8_BAR;
    }
    for (;;) {
        const bool has_next = S.next(ui + 1, nxt);
        const char* nA = has_next ? (const char*)g.A + (size_t)nxt.pm * tstep : cA; const char* nB = has_next ? (const char*)g.Bt + (size_t)nxt.pn * tstep : cB;
        for (int t = 0; t < nt; t += 2) {
            const bool last = (t == nt - 2);
            const char* a1 = cA + (size_t)(t + 1) * kstep;
            const char* a2 = last ? nA : cA + (size_t)(t + 2) * kstep; const char* b2 = last ? nB : cB + (size_t)(t + 2) * kstep;
            const char* a3 = a2 + kstep; const char* b3 = b2 + kstep;
            if (last && has_next) S.a_ready(nxt);
            if constexpr (SP2) {
            PG8_LDB(B0, 0, 0); PG8_LDB(B1, 0, 1); PG8_SCHED; PG8_LDA(At, 0, 0); PG8_STAGE(PG8_SA(1, 1), a1 + hstep, voffA);
            PG8_WAIT_V(8); PG8_WAIT_L(0); PG8_BAR; PG8_MMA(0, 0, At, B0); PG8_MMA(0, 1, At, B1); PG8_BAR; PG8_SCHED;
            PG8_LDA(At, 0, 1); PG8_STAGE(PG8_SB(0, 0), b2, voffB); PG8_STAGE(PG8_SB(0, 1), b2 + hstep, voffB); PG8_STAGE(PG8_SA(0, 0), a2, voffA);
            PG8_WAIT_V(8); PG8_WAIT_L(0); PG8_BAR; PG8_MMA(1, 0, At, B0); PG8_MMA(1, 1, At, B1); PG8_BAR; PG8_SCHED;
            PG8_LDB(B0, 1, 0); PG8_LDB(B1, 1, 1); PG8_SCHED; PG8_LDA(At, 1, 0); PG8_STAGE(PG8_SA(0, 1), a2 + hstep, voffA);
            PG8_WAIT_V(8); PG8_WAIT_L(0); PG8_BAR; PG8_MMA(0, 0, At, B0); PG8_MMA(0, 1, At, B1); PG8_BAR; PG8_SCHED;
            PG8_LDA(At, 1, 1); PG8_STAGE(PG8_SB(1, 0), b3, voffB); PG8_STAGE(PG8_SB(1, 1), b3 + hstep, voffB); PG8_STAGE(PG8_SA(1, 0), a3, voffA);
            PG8_WAIT_V(8); PG8_WAIT_L(0); PG8_BAR; PG8_MMA(1, 0, At, B0); PG8_MMA(1, 1, At, B1); PG8_BAR; PG8_SCHED;
            } else {
            PG8_LDB(B0, 0, 0); PG8_SCHED; PG8_LDA(At, 0, 0); PG8_STAGE(PG8_SA(1, 1), a1 + hstep, voffA);
            PG8_WAIT_L(8); PG8_BAR; PG8_WAIT_L(0); PG8_MMA(0, 0, At, B0); PG8_BAR; PG8_SCHED;
            PG8_LDB(B1, 0, 1); PG8_STAGE(PG8_SB(0, 0), b2, voffB);
            PG8_BAR; PG8_WAIT_L(0); PG8_MMA(0, 1, At, B1); PG8_BAR;
            PG8_LDA(At, 0, 1); PG8_STAGE(PG8_SA(0, 0), a2, voffA);
            PG8_BAR; PG8_WAIT_L(0); PG8_MMA(1, 0, At, B0); PG8_BAR; PG8_SCHED;
            PG8_STAGE(PG8_SB(0, 1), b2 + hstep, voffB);
            PG8_WAIT_V(6); PG8_BAR; PG8_MMA(1, 1, At, B1); PG8_BAR;
            PG8_LDB(B0, 1, 0); PG8_SCHED; PG8_LDA(At, 1, 0); PG8_STAGE(PG8_SA(0, 1), a2 + hstep, voffA);
            PG8_WAIT_L(8); PG8_BAR; PG8_WAIT_L(0); PG8_MMA(0, 0, At, B0); PG8_BAR; PG8_SCHED;
            PG8_LDB(B1, 1, 1); PG8_STAGE(PG8_SB(1, 0), b3, voffB);
            PG8_BAR; PG8_WAIT_L(0); PG8_MMA(0, 1, At, B1); PG8_BAR;
            PG8_LDA(At, 1, 1); PG8_STAGE(PG8_SA(1, 0), a3, voffA);
            PG8_BAR; PG8_WAIT_L(0); PG8_MMA(1, 0, At, B0); PG8_BAR; PG8_SCHED;
            PG8_STAGE(PG8_SB(1, 1), b3 + hstep, voffB);
            PG8_WAIT_V(6); PG8_BAR; PG8_MMA(1, 1, At, B1); PG8_BAR;
            }
        }
        if constexpr (ALIGN_EPI) { if (wr == 0) PG8_BAR; }
        if constexpr (!Epi::AFTER_DRAIN) { E(acc, cur, wr, wc, fr, fq); S.done(cur); }
        if (!has_next) break;
#pragma unroll
        for (int a = 0; a < 2; ++a)
#pragma unroll
            for (int b = 0; b < 2; ++b)
#pragma unroll
                for (int m = 0; m < 4; ++m)
#pragma unroll
                    for (int n = 0; n < 2; ++n) acc[a][b][m][n] = (f32x4){0.f, 0.f, 0.f, 0.f};
        cur = nxt; cA = nA; cB = nB; ++ui;
        if constexpr (ALIGN_EPI) { if (wr == 1) PG8_BAR; }
    }
    PG8_WAIT_V(0);
    if constexpr (!ALIGN_EPI) { if (wr == 0) PG8_BAR; }
    PG8_BAR;
    if constexpr (Epi::AFTER_DRAIN) { E.fused(acc, cur, wr, wc, fr, fq, lds, wid, lane); S.done(cur); }
#undef PG8_SA
#undef PG8_SB
#undef PG8_STAGE
#undef PG8_LDA
#undef PG8_LDB
#undef PG8_MMA
#undef PG8_WAIT_V
#undef PG8_WAIT_L
#undef PG8_BAR
#undef PG8_SCHED
}
}
#define XB_TMO      128
#define XB_XCNT(j)  (256  + 64 * (j))
#define XB_XSUB(j)  (1280 + 64 * (j))
#define XB_XGEN(j)  (2304 + 64 * (j))
#define XB_TOP      3328
#define XB_TOPGEN   3392
#define XCD_BAR_WORDS 3456
#define XB_SPIN_CAP (1u << 18)

__device__ __forceinline__ unsigned xb_ld(unsigned* p)              { return __hip_atomic_load(p, __ATOMIC_RELAXED, __HIP_MEMORY_SCOPE_AGENT); }
__device__ __forceinline__ unsigned xb_add(unsigned* p, unsigned v) { return __hip_atomic_fetch_add(p, v, __ATOMIC_RELAXED, __HIP_MEMORY_SCOPE_AGENT); }
__device__ __forceinline__ unsigned xb_xcc_id() { return (unsigned)__builtin_amdgcn_s_getreg((3 << 11) | 20) & 0xFu; }
#define XB_SPIN(cond, bar) do { unsigned _sp = 0; while (cond) { __builtin_amdgcn_s_sleep(1); \
    if ((++_sp & 255u) == 0u) { if (xb_ld(&(bar)[XB_TMO])) break; if (_sp > XB_SPIN_CAP) { atomicAdd(&(bar)[XB_TMO], 1u); break; } } } } while (0)

struct XcdBarrier {
    unsigned* bar; unsigned x;
    volatile LAS unsigned* st;
};

__device__ __forceinline__ XcdBarrier xcd_barrier_post(unsigned* bar, volatile LAS unsigned* st) {
    XcdBarrier b; b.bar = bar; b.x = xb_xcc_id(); b.st = st;
    if (threadIdx.x == 0) (void)xb_add(&bar[XB_XCNT(b.x)], 1u);
    return b;
}
__device__ __forceinline__ void xcd_barrier_complete(unsigned* bar, unsigned x, unsigned& nloc, unsigned& nx) {
    const unsigned G = gridDim.x * gridDim.y * gridDim.z;
    unsigned sum, cnt, mine, sp = 0u;
    for (;;) {
        sum = 0u; cnt = 0u; mine = 0u;
#pragma unroll
        for (unsigned j = 0; j < 16; ++j) { const unsigned c = xb_ld(&bar[XB_XCNT(j)]); sum += c; cnt += (c > 0u) ? 1u : 0u; mine = (j == x) ? c : mine; }
        if (sum == G) break;
        __builtin_amdgcn_s_sleep(1);
        if ((++sp & 255u) == 0u) { if (xb_ld(&bar[XB_TMO])) break; if (sp > XB_SPIN_CAP) { atomicAdd(&bar[XB_TMO], 1u); break; } }
    }
    nloc = mine > 0u ? mine : 1u; nx = cnt > 0u ? cnt : 1u;
}

__device__ __forceinline__ void xcd_barrier(const XcdBarrier& b) {
    asm volatile("s_waitcnt vmcnt(0)" ::: "memory");
    __syncthreads();
    if (threadIdx.x == 0) {
        unsigned* bar = b.bar;
        __builtin_amdgcn_s_waitcnt(0);
        unsigned nloc = b.st[0], nx = b.st[1];
        if (nloc == 0u) { xcd_barrier_complete(bar, b.x, nloc, nx); b.st[0] = nloc; b.st[1] = nx; }
        const unsigned old = xb_add(&bar[XB_XSUB(b.x)], 1u);
        const unsigned gen = old / nloc;
        if (old + 1u == (gen + 1u) * nloc) {
            __builtin_amdgcn_fence(__ATOMIC_RELEASE, "agent");
            asm volatile("s_waitcnt vmcnt(0)" ::: "memory");
            const unsigned og = xb_add(&bar[XB_TOP], 1u);
            const unsigned tg = og / nx;
            if (og + 1u == (tg + 1u) * nx) xb_add(&bar[XB_TOPGEN], 1u);
            else XB_SPIN(xb_ld(&bar[XB_TOPGEN]) == tg, bar);
            __builtin_amdgcn_fence(__ATOMIC_ACQUIRE, "agent");
            xb_add(&bar[XB_XGEN(b.x)], 1u);
            asm volatile("s_waitcnt vmcnt(0)" ::: "memory");
        } else {
            XB_SPIN(xb_ld(&bar[XB_XGEN(b.x)]) == gen, bar);
            __builtin_amdgcn_fence(__ATOMIC_ACQUIRE, "agent");
            asm volatile("s_waitcnt vmcnt(0)" ::: "memory");
        }
    }
    __syncthreads();
}


typedef f32x4 acc_t[2][2][4][2];

struct EpiStore {
    static constexpr bool PERM = true, AFTER_DRAIN = false;
    bf16* O; int ldc;
    __device__ __forceinline__ void operator()(const acc_t& acc, const pg8::Unit& u, int wr, int wc, int fr, int fq) const {
        const int row0 = u.pm * 256 + wr * 64 + fr, col0 = u.pn * 256 + wc * 32 + 8 * fq;
#pragma unroll
        for (int ai = 0; ai < 2; ++ai)
#pragma unroll
            for (int m = 0; m < 4; ++m) {
                bf16* rowp = O + (size_t)(row0 + ai * 128 + m * 16) * ldc + col0;
#pragma unroll
                for (int bj = 0; bj < 2; ++bj) {
                    const f32x4 v0 = acc[ai][bj][m][0], v1 = acc[ai][bj][m][1];
                    u32x4 w; w.x = pk2(v0[0], v0[1]); w.y = pk2(v0[2], v0[3]); w.z = pk2(v1[0], v1[1]); w.w = pk2(v1[2], v1[3]);
                    *(u32x4*)(rowp + bj * 128) = w;
                }
            }
    }
};
struct EpiRetGate {
    static constexpr bool PERM = true, AFTER_DRAIN = false;
    bf16* O; int ldc;
    __device__ __forceinline__ void operator()(const acc_t& acc, const pg8::Unit& u, int wr, int wc, int fr, int fq) const {
        const int row0 = u.pm * 256 + wr * 64 + fr, col0 = u.pn * 256 + wc * 32 + 8 * fq;
#pragma unroll
        for (int ai = 0; ai < 2; ++ai)
#pragma unroll
            for (int m = 0; m < 4; ++m) {
                bf16* rowp = O + (size_t)(row0 + ai * 128 + m * 16) * ldc + col0;
#pragma unroll
                for (int bj = 0; bj < 2; ++bj) {
                    const f32x4 v0 = acc[ai][bj][m][0], v1 = acc[ai][bj][m][1];
                    const u32x4 o = *(const u32x4*)(rowp + bj * 128);
                    u32x4 w;
                    w.x = pk2(siluf(v0[0]) * bflo(o.x), siluf(v0[1]) * bfhi(o.x)); w.y = pk2(siluf(v0[2]) * bflo(o.y), siluf(v0[3]) * bfhi(o.y));
                    w.z = pk2(siluf(v1[0]) * bflo(o.z), siluf(v1[1]) * bfhi(o.z)); w.w = pk2(siluf(v1[2]) * bflo(o.w), siluf(v1[3]) * bfhi(o.w));
                    *(u32x4*)(rowp + bj * 128) = w;
                }
            }
    }
};
template <int ACT  > struct EpiPair {
    static constexpr bool PERM = false, AFTER_DRAIN = false;
    bf16* O; int ldc;
    __device__ __forceinline__ void operator()(const acc_t& acc, const pg8::Unit& u, int wr, int wc, int fr, int fq) const {
        const int row0 = u.pm * 256 + wr * 64 + fr;
#pragma unroll
        for (int ai = 0; ai < 2; ++ai)
#pragma unroll
            for (int m = 0; m < 4; ++m) {
                bf16* rowp = O + (size_t)(row0 + ai * 128 + m * 16) * ldc;
#pragma unroll
                for (int bj = 0; bj < 2; ++bj) {
                    const int col = 16 * (u.pn * 8 + 4 * bj + wc) + 4 * fq;
                    const f32x4 a = acc[ai][bj][m][0], b = acc[ai][bj][m][1];
                    float t[4];
#pragma unroll
                    for (int e = 0; e < 4; ++e) t[e] = (ACT == 0) ? siluf(a[e]) * b[e] : a[e] * sigmf(b[e]);
                    u32x2 w; w.x = pk2(t[0], t[1]); w.y = pk2(t[2], t[3]);
                    *(u32x2*)(rowp + col) = w;
                }
            }
    }
};
struct EpiAttnIn {
    static constexpr bool PERM = false, AFTER_DRAIN = false;
    bf16* O; const float* rope;
    __device__ __forceinline__ void operator()(const acc_t& acc, const pg8::Unit& u, int wr, int wc, int fr, int fq) const {
        const int row0 = u.pm * 256 + wr * 64 + fr, part = u.pn >> 2;
        const bool lat = u.pm < 64;
        const float sc = (part == 0) ? 0.125f * LOG2E : 1.f;
#pragma unroll
        for (int ai = 0; ai < 2; ++ai)
#pragma unroll
            for (int m = 0; m < 4; ++m) {
                const int row = row0 + ai * 128 + m * 16;
                bf16* rowp = O + (size_t)row * 3072 + u.pn * 256 + wc * 32 + 4 * fq;
                f32x4 cs0 = {1.f, 0.f, 1.f, 0.f}, cs1 = {1.f, 0.f, 1.f, 0.f};
                if (part < 2 && lat) {
                    const int s = row & 8191, pos = (wc & 1) ? (s & 63) : (s >> 6);
                    const f32x4* tp = (const f32x4*)(rope + (size_t)(pos * 16 + 4 * fq) * 2);
                    cs0 = tp[0]; cs1 = tp[1];
                }
#pragma unroll
                for (int bj = 0; bj < 2; ++bj) {
                    const f32x4 x0 = acc[ai][bj][m][0], x1 = acc[ai][bj][m][1];
                    f32x4 o0, o1;
                    if (part < 2) {
                        const float c[4] = {cs0[0], cs0[2], cs1[0], cs1[2]}, sn[4] = {cs0[1], cs0[3], cs1[1], cs1[3]};
#pragma unroll
                        for (int e = 0; e < 4; ++e) { o0[e] = (x0[e] * c[e] - x1[e] * sn[e]) * sc; o1[e] = (x1[e] * c[e] + x0[e] * sn[e]) * sc; }
                    } else { o0 = x0; o1 = x1; }
                    u32x2 w0, w1; w0.x = pk2(o0[0], o0[1]); w0.y = pk2(o0[2], o0[3]); w1.x = pk2(o1[0], o1[1]); w1.y = pk2(o1[2], o1[3]);
                    *(u32x2*)(rowp + bj * 128) = w0; *(u32x2*)(rowp + bj * 128 + 16) = w1;
                }
            }
    }
};
struct EpiRetIn {
    static constexpr bool PERM = false, AFTER_DRAIN = false;
    bf16* O; const float* rope;
    __device__ __forceinline__ void operator()(const acc_t& acc, const pg8::Unit& u, int wr, int wc, int fr, int fq) const {
        const int row0 = u.pm * 256 + wr * 64 + fr, part = u.pn >> 2;
        const bool lat = u.pm < 64;
        const float sc = (part == 1) ? 0.0625f : 1.f;
#pragma unroll
        for (int ai = 0; ai < 2; ++ai)
#pragma unroll
            for (int m = 0; m < 4; ++m) {
                const int row = row0 + ai * 128 + m * 16;
                bf16* rowp = O + (size_t)row * 4096 + u.pn * 256 + wc * 32 + 4 * fq;
                const int s = row & 8191;
#pragma unroll
                for (int bj = 0; bj < 2; ++bj) {
                    const f32x4 x0 = acc[ai][bj][m][0], x1 = acc[ai][bj][m][1];
                    f32x4 o0, o1;
                    if (part < 2) {
                        f32x4 cs0 = {1.f, 0.f, 1.f, 0.f}, cs1 = {1.f, 0.f, 1.f, 0.f};
                        if (lat) {
                            const int pos = bj ? (s & 63) : (s >> 6);
                            const f32x4* tp = (const f32x4*)(rope + (size_t)(pos * 64 + 16 * wc + 4 * fq) * 2);
                            cs0 = tp[0]; cs1 = tp[1];
                        }
                        const float c[4] = {cs0[0], cs0[2], cs1[0], cs1[2]}, sn[4] = {cs0[1], cs0[3], cs1[1], cs1[3]};
#pragma unroll
                        for (int e = 0; e < 4; ++e) { o0[e] = (x0[e] * c[e] - x1[e] * sn[e]) * sc; o1[e] = (x1[e] * c[e] + x0[e] * sn[e]) * sc; }
                    } else { o0 = x0; o1 = x1; }
                    u32x2 w0, w1; w0.x = pk2(o0[0], o0[1]); w0.y = pk2(o0[2], o0[3]); w1.x = pk2(o1[0], o1[1]); w1.y = pk2(o1[2], o1[3]);
                    *(u32x2*)(rowp + bj * 128) = w0; *(u32x2*)(rowp + bj * 128 + 16) = w1;
                }
            }
    }
};

template <class Epi> __device__ __forceinline__ void run_gemm(ldsp lds, const bf16* A, const bf16* Bt, int Mrows, int N, int K, const Epi& E) {
    pg8::Gemm g{A, Bt, Mrows, N, K}; pg8::StaticOrder S; S.init(Mrows, N, (int)gridDim.x, (int)blockIdx.x);
    pg8::gemm_phase<Epi, pg8::StaticOrder, true, true>(lds, g, S, E);
}

__device__ __forceinline__ int dest_row(int mode, int half, int c) {
    if (mode == 1) return 32 * (c >> 4) + 16 * half + (c & 15);
    if (mode == 2 && c < 2048) { const int cl = c & 255, seg = cl >> 7, hf = (cl >> 6) & 1, j = cl & 63; return (c - cl) + 32 * (seg * 4 + (j >> 4)) + 16 * hf + (j & 15); }
    return c;
}
__device__ __forceinline__ void conv_w(const float* __restrict__ W, int ldw, int K, int ncols, bf16* __restrict__ WT, int mode, int half, ldsp lds, int gw, int ngw, int lane, int wave) {
    LAS float* scr = (LAS float*)(lds + wave * 16384);
    const int nblk = ncols / 32, nitems = (K / 64) * nblk;
    for (int it = gw; it < nitems; it += ngw) {
        const int kb = it / nblk, nb = it % nblk, k0 = 64 * kb, n0 = 32 * nb;
#pragma unroll 8
        for (int i = 0; i < 32; ++i) { const int kk = 2 * i + (lane >> 5); scr[kk * 33 + (lane & 31)] = W[(size_t)(k0 + kk) * ldw + n0 + (lane & 31)]; }
        asm volatile("s_waitcnt lgkmcnt(0)" ::: "memory");
        const int c = lane & 7;
#pragma unroll
        for (int j = 0; j < 4; ++j) {
            const int n = (lane >> 3) + 8 * j; const LAS float* s = scr + (8 * c) * 33 + n;
            u32x4 o; o.x = pk2(s[0 * 33], s[1 * 33]); o.y = pk2(s[2 * 33], s[3 * 33]); o.z = pk2(s[4 * 33], s[5 * 33]); o.w = pk2(s[6 * 33], s[7 * 33]);
            *(u32x4*)(WT + (size_t)dest_row(mode, half, n0 + n) * K + k0 + 8 * c) = o;
        }
        asm volatile("s_waitcnt lgkmcnt(0)" ::: "memory");
    }
}

struct Params { const float* in[26]; float* out; unsigned char* ws; int ph_lo, ph_hi; };
enum { I_X = 0, I_C, I_CTX, I_CCTX, I_MODW, I_MODB, I_NORMG, I_AWIN, I_AWOUT, I_ALAM, I_ASUBLN, I_RWIN, I_RWOUT, I_RDECAY, I_SLRE, I_SLIM, I_SLOGDT,
       I_SBRE, I_SBIM, I_SCRE, I_SCIM, I_SD, I_SWGLU, I_FWG, I_FWU, I_FWD };

__device__ __forceinline__ void conv_layer(const Params& p, int l, ldsp lds, int gw, int ngw, int lane, int wave) {
    bf16* Wb = (bf16*)(p.ws + WS_W);
    const int kind = l % 3, j = l / 3;
    if (kind == 0) {
        conv_w(p.in[I_AWIN] + (size_t)j * D * 3072, 3072, D, 3072, Wb + W_IN, 0, 0, lds, gw, ngw, lane, wave);
        conv_w(p.in[I_AWOUT] + (size_t)j * D * D, D, D, D, Wb + W_OUT, 0, 0, lds, gw, ngw, lane, wave);
    } else if (kind == 1) {
        conv_w(p.in[I_RWIN], 6144, D, 4096, Wb + W_IN, 2, 0, lds, gw, ngw, lane, wave);
        conv_w(p.in[I_RWIN] + 4096, 6144, D, 2048, Wb + W_G, 0, 0, lds, gw, ngw, lane, wave);
        conv_w(p.in[I_RWOUT], D, 2048, D, Wb + W_OUT, 0, 0, lds, gw, ngw, lane, wave);
    } else {
        conv_w(p.in[I_SWGLU], 2048, D, 1024, Wb + W_OUT, 1, 0, lds, gw, ngw, lane, wave);
        conv_w(p.in[I_SWGLU] + 1024, 2048, D, 1024, Wb + W_OUT, 1, 1, lds, gw, ngw, lane, wave);
    }
    conv_w(p.in[I_FWG] + (size_t)l * D * FF, FF, D, FF, Wb + W_GU, 1, 0, lds, gw, ngw, lane, wave);
    conv_w(p.in[I_FWU] + (size_t)l * D * FF, FF, D, FF, Wb + W_GU, 1, 1, lds, gw, ngw, lane, wave);
    conv_w(p.in[I_FWD] + (size_t)l * FF * D, D, FF, D, Wb + W_DN, 0, 0, lds, gw, ngw, lane, wave);
}

__device__ __forceinline__ void mods_phase(const Params& p, ldsp lds, int tid) {
    LAS float* sil = (LAS float*)lds;
    LAS float* red = sil + 3 * 1024;
    for (int i = tid; i < 3072; i += NTHREADS) { const float v = (i < 2048) ? p.in[I_C][i] : p.in[I_CCTX][i - 2048]; sil[i] = siluf(v); }
    __syncthreads();
    float* modv = (float*)(p.ws + WS_MOD);
    const int ks = tid >> 6, c = tid & 63;
    for (int u = blockIdx.x; u < 4 * 96; u += gridDim.x) {
        const int l = u / 96, col = (u % 96) * 64 + c;
        const float* w = p.in[I_MODW] + (size_t)l * D * 6144 + col;
        float a0 = 0.f, a1 = 0.f, a2 = 0.f;
#pragma unroll 8
        for (int k = ks * 128; k < ks * 128 + 128; ++k) { const float wv = w[(size_t)k * 6144]; a0 += sil[k] * wv; a1 += sil[1024 + k] * wv; a2 += sil[2048 + k] * wv; }
        red[(ks * 3 + 0) * 64 + c] = a0; red[(ks * 3 + 1) * 64 + c] = a1; red[(ks * 3 + 2) * 64 + c] = a2;
        __syncthreads();
        if (tid < 192) {
            const int set = tid >> 6; float s = 0.f;
#pragma unroll
            for (int k = 0; k < 8; ++k) s += red[(k * 3 + set) * 64 + c];
            modv[((size_t)l * 3 + set) * 6144 + col] = s + p.in[I_MODB][l * 6144 + col];
        }
        __syncthreads();
    }
}
__device__ __forceinline__ void rope_tables(const Params& p, int gtid, int ngt) {
    float* ra = (float*)(p.ws + WS_ROPEA); float* rr = (float*)(p.ws + WS_ROPER);
    for (int i = gtid; i < 128 * 80; i += ngt) {
        const int pos = i / 80, jj = i % 80;
        const bool isA = jj < 16; const int j = isA ? jj : jj - 16; const float quarter = isA ? 16.f : 64.f;
        const float freq = exp2f(-(float)j / quarter * 13.287712379549449f);
        float s, c; sincos_cw((float)pos * freq, s, c);
        float* dst = isA ? ra + (pos * 16 + j) * 2 : rr + (pos * 64 + j) * 2;
        dst[0] = c; dst[1] = s;
    }
}

__device__ __forceinline__ void rows_phase(const Params& p, int mode, int nrows, const float* gA, int lm_gate, int gate_idx, bool make_u, const float* gB, int lm_u, int shift_idx, int gw, int ngw, int lane, bool final_out = false) {
    const float* modv = (const float*)(p.ws + WS_MOD);
    bf16* UY = (bf16*)(p.ws + WS_UY);
    bf16* HB = (bf16*)(p.ws + WS_HB);
    for (int row = gw; row < nrows; row += ngw) {
        const int set = row < 8192 ? 0 : (row < ML ? 1 : 2);
        bf16* hrow = HB + (size_t)row * D;
        f32x4 h[4];
        if (mode == 0) {
            const float* src = row < ML ? p.in[I_X] + (size_t)row * D : p.in[I_CTX] + (size_t)(row - ML) * D;
#pragma unroll
            for (int k = 0; k < 4; ++k) h[k] = *(const f32x4*)(src + k * 256 + lane * 4);
        } else {
            f32x4 y[4]; float ss = 0.f;
#pragma unroll
            for (int k = 0; k < 4; ++k) {
                const u32x2 w = *(const u32x2*)(UY + (size_t)row * D + k * 256 + lane * 4);
                y[k] = (f32x4){bflo(w.x), bfhi(w.x), bflo(w.y), bfhi(w.y)};
                ss += y[k][0] * y[k][0] + y[k][1] * y[k][1] + y[k][2] * y[k][2] + y[k][3] * y[k][3];
            }
            const float rs = rsqrtf(wave_sum(ss) * (1.f / D) + EPS);
            const float* gate = modv + ((size_t)lm_gate * 3 + set) * 6144 + gate_idx * 1024;
#pragma unroll
            for (int k = 0; k < 4; ++k) {
                const int c0 = k * 256 + lane * 4;
                const u32x2 hw = *(const u32x2*)(hrow + c0); const f32x4 hv = {bflo(hw.x), bfhi(hw.x), bflo(hw.y), bfhi(hw.y)};
                const f32x4 gv = *(const f32x4*)(gA + c0), gt = *(const f32x4*)(gate + c0);
                h[k] = hv + gt * (y[k] * rs * gv);
            }
        }
        if (final_out) {
#pragma unroll
            for (int k = 0; k < 4; ++k) *(f32x4*)(p.out + (size_t)row * D + k * 256 + lane * 4) = h[k];
        } else {
#pragma unroll
            for (int k = 0; k < 4; ++k) { u32x2 w; w.x = pk2(h[k][0], h[k][1]); w.y = pk2(h[k][2], h[k][3]); *(u32x2*)(hrow + k * 256 + lane * 4) = w; }
        }
        if (make_u) {
            float ss = 0.f;
#pragma unroll
            for (int k = 0; k < 4; ++k) ss += h[k][0] * h[k][0] + h[k][1] * h[k][1] + h[k][2] * h[k][2] + h[k][3] * h[k][3];
            const float rs = rsqrtf(wave_sum(ss) * (1.f / D) + EPS);
            const float* shift = modv + ((size_t)lm_u * 3 + set) * 6144 + shift_idx * 1024;
            const float* scale = shift + 1024;
#pragma unroll
            for (int k = 0; k < 4; ++k) {
                const int c0 = k * 256 + lane * 4;
                const f32x4 gv = *(const f32x4*)(gB + c0), sh = *(const f32x4*)(shift + c0), sc = *(const f32x4*)(scale + c0);
                const f32x4 v = (h[k] * rs * gv) * (1.f + sc) + sh;
                u32x2 w; w.x = pk2(v[0], v[1]); w.y = pk2(v[2], v[3]);
                *(u32x2*)(UY + (size_t)row * D + c0) = w;
            }
        }
    }
}

template <int K> __device__ __forceinline__ void ctx_gemm(ldsp lds, const bf16* __restrict__ A, const bf16* __restrict__ Bt, bf16* __restrict__ Y) {
    int tid = threadIdx.x; asm volatile("" : "+v"(tid));
    const int lane = tid & 63, wid = __builtin_amdgcn_readfirstlane(tid >> 6), r = lane & 31, hh = lane >> 5;
    constexpr int KQ = K / 8, NS = KQ / 16, NB = (NS % 11 == 0) ? 11 : 8;
    static_assert(NS % NB == 0, "ctx_gemm K split");
    LAS float* red = (LAS float*)lds;
    for (int tile = blockIdx.x; tile < 512; tile += gridDim.x) {
        const int tm = tile >> 5, tn = tile & 31;
        const bf16* ap = A + (size_t)(ML + tm * 32 + r) * K + wid * KQ + hh * 8;
        const bf16* bp = Bt + (size_t)(tn * 32 + r) * K + wid * KQ + hh * 8;
        f32x16 acc;
#pragma unroll
        for (int e = 0; e < 16; ++e) acc[e] = 0.f;
#pragma unroll 1
        for (int s0 = 0; s0 < NS; s0 += NB) {
            bf16x8 af[NB], bfr[NB];
#pragma unroll
            for (int s = 0; s < NB; ++s) { af[s] = *(const bf16x8*)(ap + (s0 + s) * 16); bfr[s] = *(const bf16x8*)(bp + (s0 + s) * 16); }
#pragma unroll
            for (int s = 0; s < NB; ++s) acc = mfma32(af[s], bfr[s], acc);
        }
        __syncthreads();
        LAS float* rp = red + (wid * 32) * 33 + r;
#pragma unroll
        for (int e = 0; e < 16; ++e) rp[crow(e, hh) * 33] = acc[e];
        __syncthreads();
        if (tid < 256) {
            const int row = tid >> 3, c4 = (tid & 7) * 4;
            const LAS float* sp = red + row * 33 + c4;
            float v[4];
#pragma unroll
            for (int e = 0; e < 4; ++e) { float a = 0.f;
#pragma unroll
                for (int k = 0; k < 8; ++k) a += sp[k * 32 * 33 + e];
                v[e] = a; }
            u32x2 w; w.x = pk2(v[0], v[1]); w.y = pk2(v[2], v[3]);
            *(u32x2*)(Y + (size_t)(ML + tm * 32 + row) * D + tn * 32 + c4) = w;
        }
    }
}

constexpr int AT_KST = 272, AT_VST = 320;
constexpr int AT_KBUF = 64 * AT_KST, AT_VBUF = 64 * AT_VST, AT_STAGE = AT_KBUF + AT_VBUF;
static_assert(3 * AT_STAGE <= LDS_BYTES - 64 && 4 * 64 * 64 * 4 <= 3 * AT_STAGE, "attention LDS");

__device__ __forceinline__ void attn_phase(ldsp lds, const bf16* __restrict__ P, bf16* __restrict__ O, const float* lamv, const float* subln, float lam_init, bool with_ctx) {
    int tid = threadIdx.x; asm volatile("" : "+v"(tid));
    const int lane = tid & 63, wid = __builtin_amdgcn_readfirstlane(tid >> 6), r = lane & 31, hh = lane >> 5;
    const int q4 = (lane & 15) >> 2, p4 = lane & 3, blk = (lane >> 4) & 1;
    const int qb = wid & 3, sh = wid >> 2;
    float lam;
    { const float a = lamv[lane] * lamv[64 + lane], b = lamv[128 + lane] * lamv[192 + lane]; lam = expf(wave_sum(a)) - expf(wave_sum(b)) + lam_init; }
    const int G = gridDim.x, bid = blockIdx.x;
    const int vb = (G % 8 == 0) ? (bid % 8) * (G / 8) + bid / 8 : bid;
    const int NU = 1024 + (with_ctx ? 32 : 0);
    const int srow = tid >> 4, sch = tid & 15;
    for (int u = vb; u < NU; u += G) {
        int b, h, qrow0, NT;
        if (u < 1024) { b = u >> 9; h = (u >> 6) & 7; qrow0 = b * SEQ + (u & 63) * 128; NT = 132; }
        else { const int v = u - 1024; b = v >> 4; h = (v >> 1) & 7; qrow0 = ML + b * CTX + (v & 1) * 128; NT = 4; }
        bf16x8 qf[4];
        {
            const bf16* qp = P + (size_t)(qrow0 + qb * 32 + r) * 3072 + h * 128 + sh * 64 + hh * 8;
#pragma unroll
            for (int d0 = 0; d0 < 4; ++d0) qf[d0] = *(const bf16x8*)(qp + d0 * 16);
        }
        f32x16 Oa[4];
#pragma unroll
        for (int d0 = 0; d0 < 4; ++d0)
#pragma unroll
            for (int e = 0; e < 16; ++e) Oa[d0][e] = 0.f;
        float mrun = 0.f, lrun = 0.f, mx;
        f32x16 zero16;
#pragma unroll
        for (int e = 0; e < 16; ++e) zero16[e] = 0.f;
        u32x4 sA[4], sB[4];
        const bf16* gK = P + (size_t)srow * 3072 + 1024 + h * 128 + sch * 8;
        const int ctx0 = ML + b * CTX, lat0 = b * SEQ - 256;
#define AT_TROW(t) ((t) < 4 ? ctx0 + (t) * 64 : lat0 + (t) * 64)
#define AT_LOAD(sreg, t) do { const bf16* g_ = gK + (size_t)AT_TROW(t) * 3072; sreg[0] = *(const u32x4*)g_; sreg[1] = *(const u32x4*)(g_ + 32 * 3072); sreg[2] = *(const u32x4*)(g_ + 1024); sreg[3] = *(const u32x4*)(g_ + 32 * 3072 + 1024); } while (0)
#define AT_STORE(sreg, so) do { ldsp kb_ = lds + (so) + srow * AT_KST + sch * 16; *(LAS u32x4*)kb_ = sreg[0]; *(LAS u32x4*)(kb_ + 32 * AT_KST) = sreg[1]; \
            ldsp vb_ = lds + (so) + AT_KBUF + srow * AT_VST + sch * 16; *(LAS u32x4*)vb_ = sreg[2]; *(LAS u32x4*)(vb_ + 32 * AT_VST) = sreg[3]; } while (0)
#define AT_QK(N0, N1, so, INIT) do { cldsp kb_ = lds + (so) + r * AT_KST + (sh * 64 + hh * 8) * 2; \
            _Pragma("unroll") for (int d0 = 0; d0 < 4; ++d0) { \
                const bf16x8 ka_ = *(const LAS bf16x8*)(kb_ + d0 * 32), kc_ = *(const LAS bf16x8*)(kb_ + 32 * AT_KST + d0 * 32); \
                if (d0 == 0) { N0 = mfma32(ka_, qf[0], zero16); N1 = mfma32(kc_, qf[0], zero16); } \
                else { N0 = mfma32(ka_, qf[d0], N0); N1 = mfma32(kc_, qf[d0], N1); } } } while (0)
#define AT_MAX(N0, N1) do { float ma_, mb_; \
            asm volatile("s_nop 15\n\ts_nop 7\n\tv_max3_f32 %0, %1, %2, %3" : "=v"(ma_) : "v"(N0[0]), "v"(N0[1]), "v"(N1[0])); \
            asm volatile("v_max3_f32 %0, %1, %2, %3" : "=v"(mb_) : "v"(N0[2]), "v"(N0[3]), "v"(N1[1])); \
            asm volatile("v_max3_f32 %0, %1, %2, %3" : "=v"(ma_) : "v"(ma_), "v"(N1[2]), "v"(N1[3])); \
            _Pragma("unroll") for (int e = 4; e < 16; e += 4) { \
                asm volatile("v_max3_f32 %0, %1, %2, %3" : "=v"(ma_) : "v"(ma_), "v"(N0[e]), "v"(N0[e + 1])); \
                asm volatile("v_max3_f32 %0, %1, %2, %3" : "=v"(mb_) : "v"(mb_), "v"(N0[e + 2]), "v"(N0[e + 3])); \
                asm volatile("v_max3_f32 %0, %1, %2, %3" : "=v"(ma_) : "v"(ma_), "v"(N1[e]), "v"(N1[e + 1])); \
                asm volatile("v_max3_f32 %0, %1, %2, %3" : "=v"(mb_) : "v"(mb_), "v"(N1[e + 2]), "v"(N1[e + 3])); } \
            mx = __builtin_fmaxf(ma_, mb_); mx = __builtin_fmaxf(mx, __shfl_xor(mx, 32)); } while (0)
#define AT_PV(s, PF, vbase) do { _Pragma("unroll") for (int d0 = 0; d0 < 4; ++d0) { \
                const s16x4 lo_ = tr4((vbase) + (16 * (s)) * AT_VST + d0 * 64), hi_ = tr4((vbase) + (16 * (s) + 8) * AT_VST + d0 * 64); \
                Oa[d0] = mfma32(cat8(lo_, hi_), PF, Oa[d0]); } } while (0)
#define AT_MIX(npre, nper, niter, nv) do { __builtin_amdgcn_sched_group_barrier(0x100, (npre), 0); \
            _Pragma("unroll") for (int i_ = 0; i_ < 8; ++i_) { __builtin_amdgcn_sched_group_barrier(0x008, 1, 0); \
                if (i_ < (niter)) __builtin_amdgcn_sched_group_barrier(0x100, (nper), 0); \
                __builtin_amdgcn_sched_group_barrier(0x002, (nv), 0); } } while (0)
#define AT_SOFT(P0, P1, t) do { \
            AT_MAX(P0, P1); \
            if (__builtin_amdgcn_ballot_w64(!(__builtin_fabsf(mx) <= 60.f) || mrun != 0.f) != 0ull) { \
                const float mnew_ = ((t) == 0) ? mx : fmaxf(mrun, mx), alpha_ = ((t) == 0) ? 1.f : fexp2(mrun - mnew_); mrun = mnew_; \
                _Pragma("unroll") for (int e = 0; e < 16; ++e) { P0[e] -= mnew_; P1[e] -= mnew_; } \
                lrun *= alpha_; \
                if (__builtin_amdgcn_ballot_w64(alpha_ != 1.f) != 0ull) { \
                    _Pragma("unroll") for (int d0 = 0; d0 < 4; ++d0) _Pragma("unroll") for (int e = 0; e < 16; ++e) Oa[d0][e] *= alpha_; } \
            } \
            float sum_ = 0.f; \
            _Pragma("unroll") for (int e = 0; e < 16; ++e) { P0[e] = fexp2(P0[e]); sum_ += P0[e]; } \
            pf0 = pack8<0>(P0); pf1 = pack8<8>(P0); \
            _Pragma("unroll") for (int e = 0; e < 16; ++e) { P1[e] = fexp2(P1[e]); sum_ += P1[e]; } \
            pf2 = pack8<0>(P1); pf3 = pack8<8>(P1); \
            lrun += sum_; } while (0)
#define AT_PVALL(so) do { cldsp vbase_ = lds + (so) + AT_KBUF + (4 * hh + q4) * AT_VST + (16 * blk + 4 * p4) * 2; \
            AT_PV(0, pf0, vbase_); AT_PV(1, pf1, vbase_); AT_PV(2, pf2, vbase_); AT_PV(3, pf3, vbase_); } while (0)
#define AT_HEAD(S, t) do { __builtin_amdgcn_sched_barrier(0); AT_STORE(S, sW); { const int tn3_ = ((t) + 3 < NT) ? (t) + 3 : NT - 1; AT_LOAD(S, tn3_); } } while (0)
#define AT_TAIL() do { { const int t_ = sVp; sVp = sV; sV = sW; sW = t_; } __syncthreads(); } while (0)
        AT_LOAD(sA, 0); AT_STORE(sA, 0);
        AT_LOAD(sB, 1); AT_LOAD(sA, 2);
        __syncthreads();
        int sVp = 2 * AT_STAGE, sV = 0, sW = AT_STAGE;
        f32x16 c0, c1;
        bf16x8 pf0 = {0, 0, 0, 0, 0, 0, 0, 0}, pf1 = pf0, pf2 = pf0, pf3 = pf0;
#define AT_STEP_A(S, t) do { AT_HEAD(S, t); AT_QK(c0, c1, sV, 0.f); AT_SOFT(c0, c1, t); __builtin_amdgcn_sched_barrier(0); AT_PVALL(sV); AT_TAIL(); } while (0)
#define AT_STEP_B(S, t) do { AT_HEAD(S, t); AT_QK(c0, c1, sV, 0.f); { const int sp_ = ((t) > 0) ? sVp : sV; AT_PVALL(sp_); } __builtin_amdgcn_sched_barrier(0); AT_SOFT(c0, c1, t); AT_TAIL(); } while (0)
        if (sh == 0) {
            for (int t = 0; t < NT; t += 2) { AT_STEP_A(sB, t); AT_STEP_A(sA, t + 1); }
        } else {
            for (int t = 0; t < NT; t += 2) { AT_STEP_B(sB, t); AT_STEP_B(sA, t + 1); }
            AT_PVALL(sVp);
        }
        __syncthreads();
        const float ltot = lrun + __shfl_xor(lrun, 32);
        LAS float* X = (LAS float*)lds + (size_t)(qb * 64) * 64 + lane;
        if (sh == 1) {
            const float sc = lam / ltot;
#pragma unroll
            for (int d0 = 0; d0 < 4; ++d0)
#pragma unroll
                for (int e = 0; e < 16; ++e) X[(d0 * 16 + e) * 64] = Oa[d0][e] * sc;
        }
        __syncthreads();
        if (sh == 0) {
            const float inv0 = 1.f / ltot;
            float ss = 0.f;
#pragma unroll
            for (int d0 = 0; d0 < 4; ++d0)
#pragma unroll
                for (int e = 0; e < 16; ++e) { const float v = Oa[d0][e] * inv0 - X[(d0 * 16 + e) * 64]; Oa[d0][e] = v; ss += v * v; }
            ss += __shfl_xor(ss, 32);
            const float rs = rsqrtf(ss * (1.f / 128.f) + EPS) * (1.f - lam_init);
            bf16* op = O + (size_t)(qrow0 + qb * 32 + r) * D + h * 128;
#pragma unroll
            for (int d0 = 0; d0 < 4; ++d0)
#pragma unroll
                for (int g4 = 0; g4 < 4; ++g4) {
                    const int dv = 32 * d0 + 8 * g4 + 4 * hh;
                    const f32x4 gs = *(const f32x4*)(subln + dv);
                    u32x2 w; w.x = pk2(Oa[d0][4 * g4 + 0] * rs * gs[0], Oa[d0][4 * g4 + 1] * rs * gs[1]);
                    w.y = pk2(Oa[d0][4 * g4 + 2] * rs * gs[2], Oa[d0][4 * g4 + 3] * rs * gs[3]);
                    *(u32x2*)(op + dv) = w;
                }
        }
        __syncthreads();
    }
#undef AT_TROW
#undef AT_LOAD
#undef AT_STORE
#undef AT_QK
#undef AT_PV
#undef AT_MAX
#undef AT_MIX
#undef AT_HEAD
#undef AT_STEP_A
#undef AT_STEP_B
#undef AT_TAIL
#undef AT_SOFT
#undef AT_PVALL
}

constexpr int RB_KST = 528;
constexpr int RB_VST = 80;
constexpr int RB_RST = 528;
constexpr int RB_K = 0, RB_V = 64 * RB_KST, RB_R = RB_V + 64 * RB_VST, RB_BUF = RB_R + 32 * RB_RST;
static_assert(2 * RB_BUF + 8 * 1024 <= LDS_BYTES - 64, "RB LDS");

__device__ __forceinline__ void retn_rb(ldsp lds, const bf16* __restrict__ P, bf16* __restrict__ OF, bf16* __restrict__ OB, const float* decay_logit) {
    int tid = threadIdx.x; asm volatile("" : "+v"(tid));
    const int lane = tid & 63, wid = __builtin_amdgcn_readfirstlane(tid >> 6), r = lane & 31, hh = lane >> 5;
    const int q4 = (lane & 15) >> 2, p4 = lane & 3, blk = (lane >> 4) & 1;
    const int n16 = lane & 15, quad = lane >> 4, tq = wid & 3, dq = wid >> 2;
    const int G_ = gridDim.x, bid_ = blockIdx.x, vb_ = (G_ % 8 == 0) ? (bid_ % 8) * (G_ / 8) + bid_ / 8 : bid_;
    for (int it = vb_; it < 256; it += G_) {
        const int b = it >> 7, h = (it >> 5) & 3, dir = (it >> 4) & 1, sl = it & 15;
        const float dl = decay_logit[dir * 4 + h];
        const float log2g = -log2f(1.f + expf(-dl));
        const float g64 = exp2f(64.f * log2g);
        bf16* Oout = (dir ? OB : OF) + h * 512 + sl * 32 + dq * 16 + n16;
        f32x16 R;
#pragma unroll
        for (int e = 0; e < 16; ++e) R[e] = 0.f;
        u32x4 k0[4], k1[4], v0, v1;
        bf16x8 qa[8], qb[8], qc[8];
        float qd[4];
#pragma unroll
        for (int j = 0; j < 4; ++j) qd[j] = exp2f((float)(tq * 16 + quad * 4 + j + 1) * log2g);
        const float kd = exp2f((float)(63 - (tid >> 2)) * log2g);
#define RB_ROWBASE(c) (((c) < 4) ? ML + b * CTX + (dir ? 3 - (c) : (c)) * 64 : b * SEQ + (dir ? 127 - ((c) - 4) : ((c) - 4)) * 64)
#define RB_IOFF(i) (dir ? 63 - (i) : (i))
        const long kstep_ = dir ? -16L * 4096 : 16L * 4096;
        const bf16* kp_ = P + (size_t)RB_IOFF(tid >> 5) * 4096 + 1024 + h * 256 + (tid & 31) * 8;
        const bf16* vp_ = P + (size_t)RB_IOFF((tid >> 2) & 63) * 4096 + 2048 + h * 512 + sl * 32 + (tid & 3) * 8;
        const bf16* qp_ = P + (size_t)RB_IOFF(tq * 16 + n16) * 4096 + h * 256 + quad * 8;
        bf16* op_ = (dir ? OB : OF) + h * 512 + sl * 32 + (size_t)RB_IOFF(tq * 16 + (lane >> 2)) * 2048 + (lane & 3) * 8;
        LAS bf16* wt_ = (LAS bf16*)(lds + 2 * RB_BUF + (wid & 3) * 2048);
#define RB_LOADKV(kreg, vreg, c) do { const size_t ro_ = (size_t)RB_ROWBASE(c) * 4096; \
            _Pragma("unroll") for (int k_ = 0; k_ < 4; ++k_) kreg[k_] = *(const u32x4*)(kp_ + ro_ + k_ * kstep_); \
            if (tid < 256) vreg = *(const u32x4*)(vp_ + ro_); } while (0)
#define RB_LOADQ(QF, c) do { const bf16* q_ = qp_ + (size_t)RB_ROWBASE(c) * 4096; \
            _Pragma("unroll") for (int ks = 0; ks < 8; ++ks) QF[ks] = *(const bf16x8*)(q_ + ks * 32); } while (0)
#define RB_STOREKV(kreg, vreg, bo) do { _Pragma("unroll") for (int k_ = 0; k_ < 4; ++k_) { const int cc_ = tid + 512 * k_, i_ = cc_ >> 5, ch_ = cc_ & 31; \
                *(LAS u32x4*)(lds + (bo) + RB_K + i_ * RB_KST + ch_ * 16) = kreg[k_]; } \
            if (tid < 256) { const int i_ = tid >> 2, ch_ = tid & 3; u32x4 w_; \
                w_.x = pk2(bflo(vreg.x) * kd, bfhi(vreg.x) * kd); w_.y = pk2(bflo(vreg.y) * kd, bfhi(vreg.y) * kd); w_.z = pk2(bflo(vreg.z) * kd, bfhi(vreg.z) * kd); w_.w = pk2(bflo(vreg.w) * kd, bfhi(vreg.w) * kd); \
                *(LAS u32x4*)(lds + (bo) + RB_V + i_ * RB_VST + ch_ * 16) = w_; } } while (0)
#define RB_STORER(bo) do { _Pragma("unroll") for (int g4 = 0; g4 < 4; ++g4) { u32x2 w_; w_.x = pk2(R[4 * g4], R[4 * g4 + 1]); w_.y = pk2(R[4 * g4 + 2], R[4 * g4 + 3]); \
                *(LAS u32x2*)(lds + (bo) + RB_R + r * RB_RST + (32 * wid + 8 * g4 + 4 * hh) * 2) = w_; } } while (0)
#define RB_STEP(QF, QL, KS, VS, c, cur, nxt) do { \
            RB_STOREKV(KS, VS, nxt); \
            { const int c3_ = ((c) + 3 < 132) ? (c) + 3 : 131; RB_LOADKV(KS, VS, c3_); } \
            if (wid < 4) { const int c2_ = ((c) + 2 < 132) ? (c) + 2 : 131; RB_LOADQ(QL, c2_); } \
            if (wid < 4) { f32x4 acc0_ = {0.f, 0.f, 0.f, 0.f}, acc1_ = {0.f, 0.f, 0.f, 0.f}; \
              cldsp rt_ = lds + (cur) + RB_R + n16 * RB_RST + quad * 16; \
              _Pragma("unroll") for (int ks = 0; ks < 8; ++ks) { \
                  acc0_ = mfma16(QF[ks], *(const LAS bf16x8*)(rt_ + ks * 64), acc0_); \
                  acc1_ = mfma16(QF[ks], *(const LAS bf16x8*)(rt_ + 16 * RB_RST + ks * 64), acc1_); } \
              _Pragma("unroll") for (int j = 0; j < 4; ++j) { wt_[(4 * quad + j) * 40 + n16] = (bf16)(pk2(acc0_[j] * qd[j], 0.f) & 0xffffu); \
                  wt_[(4 * quad + j) * 40 + 16 + n16] = (bf16)(pk2(acc1_[j] * qd[j], 0.f) & 0xffffu); } \
              const u32x4 ov_ = *(const LAS u32x4*)(wt_ + (lane >> 2) * 40 + (lane & 3) * 8); \
              *(u32x4*)(op_ + (size_t)RB_ROWBASE(c) * 2048) = ov_; } \
            { _Pragma("unroll") for (int e = 0; e < 16; ++e) R[e] *= g64; \
              cldsp Kb_ = lds + (cur) + RB_K + (8 * hh + q4) * RB_KST + (32 * wid + 16 * blk + 4 * p4) * 2; \
              cldsp Vb_ = lds + (cur) + RB_V + (8 * hh + q4) * RB_VST + (16 * blk + 4 * p4) * 2; \
              _Pragma("unroll") for (int ks = 0; ks < 4; ++ks) { \
                  const s16x4 alo_ = tr4(Kb_ + (16 * ks) * RB_KST), ahi_ = tr4(Kb_ + (16 * ks + 4) * RB_KST); \
                  const s16x4 blo_ = tr4(Vb_ + (16 * ks) * RB_VST), bhi_ = tr4(Vb_ + (16 * ks + 4) * RB_VST); \
                  R = mfma32(cat8(alo_, ahi_), cat8(blo_, bhi_), R); } } \
            RB_STORER(nxt); \
            __syncthreads(); __builtin_amdgcn_sched_barrier(0); } while (0)
        RB_LOADKV(k0, v0, 0); RB_STOREKV(k0, v0, 0); RB_STORER(0);
        RB_LOADKV(k1, v1, 1); RB_LOADKV(k0, v0, 2); if (wid < 4) { RB_LOADQ(qa, 0); RB_LOADQ(qb, 1); }
        __syncthreads();
        for (int c = 0; c < 132; c += 6) {
            RB_STEP(qa, qc, k1, v1, c, 0, RB_BUF);
            RB_STEP(qb, qa, k0, v0, c + 1, RB_BUF, 0);
            RB_STEP(qc, qb, k1, v1, c + 2, 0, RB_BUF);
            RB_STEP(qa, qc, k0, v0, c + 3, RB_BUF, 0);
            RB_STEP(qb, qa, k1, v1, c + 4, 0, RB_BUF);
            RB_STEP(qc, qb, k0, v0, c + 5, RB_BUF, 0);
        }
    }
#undef RB_ROWBASE
#undef RB_IOFF
#undef RB_LOADKV
#undef RB_LOADQ
#undef RB_STOREKV
#undef RB_STORER
#undef RB_STEP
}

constexpr int RA_QST = 528, RA_VST = 1040, RA_SST = 144;
constexpr int RA_Q = 0, RA_K = 64 * RA_QST, RA_V = 2 * 64 * RA_QST, RA_S = RA_V + 64 * RA_VST, RA_ST = RA_S + 64 * RA_SST;
static_assert(RA_ST + 64 * 4 * 4 <= LDS_BYTES, "RA LDS");

__device__ __forceinline__ void retn_ra(ldsp lds, const bf16* __restrict__ P, bf16* __restrict__ OF, const bf16* __restrict__ OB, const float* decay_logit) {
    int tid = threadIdx.x; asm volatile("" : "+v"(tid));
    const int lane = tid & 63, wid = __builtin_amdgcn_readfirstlane(tid >> 6), r = lane & 31, hh = lane >> 5;
    const int q4 = (lane & 15) >> 2, p4 = lane & 3, blk = (lane >> 4) & 1;
    for (int u = blockIdx.x; u < 2 * 4 * 132; u += gridDim.x) {
        const int b = u / 528, h = (u / 132) & 3, cc = u % 132;
        const int rowbase = cc < 4 ? ML + b * CTX + cc * 64 : b * SEQ + (cc - 4) * 64;
        const float lgf = -log2f(1.f + expf(-decay_logit[h])), lgb = -log2f(1.f + expf(-decay_logit[4 + h]));
#pragma unroll
        for (int k = 0; k < 4; ++k) {
            const int c = tid + 512 * k, i = c >> 5, ch = c & 31;
            const bf16* g = P + (size_t)(rowbase + i) * 4096 + h * 256 + ch * 8;
            *(LAS u32x4*)(lds + RA_Q + i * RA_QST + ch * 16) = *(const u32x4*)g;
            *(LAS u32x4*)(lds + RA_K + i * RA_QST + ch * 16) = *(const u32x4*)(g + 1024);
        }
#pragma unroll
        for (int k = 0; k < 8; ++k) {
            const int c = tid + 512 * k, i = c >> 6, ch = c & 63;
            *(LAS u32x4*)(lds + RA_V + i * RA_VST + ch * 16) = *(const u32x4*)(P + (size_t)(rowbase + i) * 4096 + 2048 + h * 512 + ch * 8);
        }
        __syncthreads();
        if (wid < 4) {
            const int kj = wid >> 1, qi = wid & 1;
            f32x16 s;
#pragma unroll
            for (int e = 0; e < 16; ++e) s[e] = 0.f;
#pragma unroll
            for (int ks = 0; ks < 16; ++ks) {
                const bf16x8 a = *(const LAS bf16x8*)(lds + RA_K + (kj * 32 + r) * RA_QST + (ks * 16 + hh * 8) * 2);
                const bf16x8 bb = *(const LAS bf16x8*)(lds + RA_Q + (qi * 32 + r) * RA_QST + (ks * 16 + hh * 8) * 2);
                s = mfma32(a, bb, s);
            }
            const int q = qi * 32 + r;
#pragma unroll
            for (int g4 = 0; g4 < 4; ++g4) {
                float v[4];
#pragma unroll
                for (int e = 0; e < 4; ++e) {
                    const int k = kj * 32 + 8 * g4 + 4 * hh + e, df = q - k;
                    float dcy = 0.f;
                    if (df >= 0) dcy += exp2f((float)df * lgf);
                    if (df <= 0) dcy += exp2f((float)(-df) * lgb);
                    v[e] = s[4 * g4 + e] * dcy;
                }
                u32x2 w; w.x = pk2(v[0], v[1]); w.y = pk2(v[2], v[3]);
                *(LAS u32x2*)(lds + RA_S + q * RA_SST + (kj * 32 + 8 * g4 + 4 * hh) * 2) = w;
            }
        }
        __syncthreads();
        u32x4 fa[4], fb[4];
#define RA_TLOAD(k0) do { _Pragma("unroll") for (int k = 0; k < 4; ++k) { const int c = tid + 512 * ((k0) + k), i = c >> 6, ch = c & 63; \
                const size_t o_ = (size_t)(rowbase + i) * 2048 + h * 512 + ch * 8; fa[k] = *(const u32x4*)(OF + o_); fb[k] = *(const u32x4*)(OB + o_); } } while (0)
#define RA_ADD2(x, y) pk2(bflo(x) + bflo(y), bfhi(x) + bfhi(y))
#define RA_TSTORE(k0) do { _Pragma("unroll") for (int k = 0; k < 4; ++k) { const int c = tid + 512 * ((k0) + k), i = c >> 6, ch = c & 63; u32x4 w_; \
                w_.x = RA_ADD2(fa[k].x, fb[k].x); w_.y = RA_ADD2(fa[k].y, fb[k].y); w_.z = RA_ADD2(fa[k].z, fb[k].z); w_.w = RA_ADD2(fa[k].w, fb[k].w); \
                *(LAS u32x4*)(lds + i * RA_VST + ch * 16) = w_; } } while (0)
        RA_TLOAD(0);
        const int qi = wid & 1, dvr = (wid >> 1) * 128;
        f32x16 acc[4];
#pragma unroll
        for (int db = 0; db < 4; ++db)
#pragma unroll
            for (int e = 0; e < 16; ++e) acc[db][e] = 0.f;
        {
            cldsp Vb = lds + RA_V + (8 * hh + q4) * RA_VST + (dvr + 16 * blk + 4 * p4) * 2;
#pragma unroll
            for (int ks = 0; ks < 4; ++ks) {
                const bf16x8 a = *(const LAS bf16x8*)(lds + RA_S + (qi * 32 + r) * RA_SST + (ks * 16 + hh * 8) * 2);
#pragma unroll
                for (int db = 0; db < 4; ++db) {
                    const s16x4 lo = tr4(Vb + (16 * ks) * RA_VST + db * 64), hi = tr4(Vb + (16 * ks + 4) * RA_VST + db * 64);
                    acc[db] = mfma32(a, cat8(lo, hi), acc[db]);
                }
            }
        }
        RA_TSTORE(0); RA_TLOAD(4); RA_TSTORE(4);
        __syncthreads();
        float ssq[16];
#pragma unroll
        for (int e = 0; e < 16; ++e) {
            const LAS bf16* tp = (const LAS bf16*)(lds + (qi * 32 + crow(e, hh)) * RA_VST) + dvr + r;
            float s2 = 0.f;
#pragma unroll
            for (int db = 0; db < 4; ++db) { const float v = acc[db][e] + __uint_as_float((unsigned)tp[db * 32] << 16); acc[db][e] = v; s2 += v * v; }
            s2 += __shfl_xor(s2, 1); s2 += __shfl_xor(s2, 2); s2 += __shfl_xor(s2, 4); s2 += __shfl_xor(s2, 8); s2 += __shfl_xor(s2, 16);
            ssq[e] = s2;
        }
        LAS float* st = (LAS float*)(lds + RA_ST);
        if (r == 0) {
#pragma unroll
            for (int e = 0; e < 16; ++e) st[(qi * 32 + crow(e, hh)) * 4 + (wid >> 1)] = ssq[e];
        }
        __syncthreads();
#pragma unroll
        for (int e = 0; e < 16; ++e) {
            const int q = qi * 32 + crow(e, hh);
            const f32x4 sv = *(const LAS f32x4*)(st + q * 4);
            const float rs = rsqrtf((sv[0] + sv[1] + sv[2] + sv[3]) * (1.f / 512.f) + EPS);
            LAS bf16* tp = (LAS bf16*)(lds + q * RA_VST) + dvr + r;
#pragma unroll
            for (int db = 0; db < 4; ++db) tp[db * 32] = (bf16)(pk2(acc[db][e] * rs, 0.f) & 0xffffu);
        }
        __syncthreads();
#pragma unroll
        for (int k = 0; k < 8; ++k) { const int c = tid + 512 * k, i = c >> 6, ch = c & 63;
            *(u32x4*)(OF + (size_t)(rowbase + i) * 2048 + h * 512 + ch * 8) = *(const LAS u32x4*)(lds + i * RA_VST + ch * 16); }
#undef RA_TLOAD
#undef RA_ADD2
#undef RA_TSTORE
        __syncthreads();
    }
}

__device__ __forceinline__ int s5_row0(int cidx) { const int b = cidx / 264, cl = cidx % 264; return cl < 8 ? ML + b * CTX + cl * 32 : b * SEQ + (cl - 8) * 32; }

__device__ __forceinline__ void s5_tables(const Params& p, ldsp lds, int tid) {
    LAS float* E = (LAS float*)lds;
    LAS float* BB = E + 33 * 128;
    LAS float* CC = BB + 2048;
    bf16* Mt = (bf16*)(p.ws + WS_P + P_S5_M); bf16* Wt = (bf16*)(p.ws + WS_P + P_S5_W); bf16* Zt = (bf16*)(p.ws + WS_P + P_S5_Z);
    float* A32 = (float*)(p.ws + WS_A32);
    for (int u = blockIdx.x; u < 128; u += gridDim.x) {
        const int g = u >> 1, dir = u & 1, dg = dir * 64 + g;
        const float dt = expf(p.in[I_SLOGDT][dg]);
        for (int i = tid; i < 33 * 64; i += NTHREADS) {
            const int k = i >> 6, pp = i & 63;
            const float lr = p.in[I_SLRE][dg * 64 + pp], li = p.in[I_SLIM][dg * 64 + pp];
            const float mag = expf((float)k * (lr * dt)); float s, c; sincos_cw((float)k * (li * dt), s, c);
            E[i * 2] = mag * c; E[i * 2 + 1] = mag * s;
        }
        for (int i = tid; i < 1024; i += NTHREADS) {
            const int pp = i >> 4;
            const float lr = p.in[I_SLRE][dg * 64 + pp], li = p.in[I_SLIM][dg * 64 + pp];
            const float mag = expf(lr * dt); float s, c; sincos_cw(li * dt, s, c);
            const float nr = mag * c - 1.f, ni = mag * s, den = 1.f / (lr * lr + li * li);
            const float fr = (nr * lr + ni * li) * den, fi = (ni * lr - nr * li) * den;
            const float br = p.in[I_SBRE][(size_t)dg * 1024 + i], bi = p.in[I_SBIM][(size_t)dg * 1024 + i];
            BB[i * 2] = fr * br - fi * bi; BB[i * 2 + 1] = fr * bi + fi * br;
            CC[i * 2] = p.in[I_SCRE][(size_t)dg * 1024 + i]; CC[i * 2 + 1] = p.in[I_SCIM][(size_t)dg * 1024 + i];
        }
        __syncthreads();
        if (tid < 64) { A32[(size_t)(g * 2 + dir) * 128 + tid * 2] = E[(32 * 64 + tid) * 2]; A32[(size_t)(g * 2 + dir) * 128 + tid * 2 + 1] = E[(32 * 64 + tid) * 2 + 1]; }
        const size_t tb = (size_t)(g * 2 + dir);
        for (int i = tid; i < 33 * 256; i += NTHREADS) {
            const int k1 = i >> 8, ci = (i >> 4) & 15, bj = i & 15;
            float acc = 0.f;
            if (k1 > 0) {
                const int k = k1 - 1;
                for (int pp = 0; pp < 64; ++pp) {
                    const float er = E[(k * 64 + pp) * 2], ei = E[(k * 64 + pp) * 2 + 1], cr = CC[(ci * 64 + pp) * 2], cim = CC[(ci * 64 + pp) * 2 + 1];
                    const float xr = cr * er - cim * ei, xi = cr * ei + cim * er;
                    acc += xr * BB[(pp * 16 + bj) * 2] - xi * BB[(pp * 16 + bj) * 2 + 1];
                }
            }
            Mt[tb * (33 * 256) + i] = (bf16)(pk2(acc, 0.f) & 0xffffu);
        }
        for (int i = tid; i < 64 * 512; i += NTHREADS) {
            const int pp = i >> 9, col = i & 511, s = col >> 4, j = col & 15, kk = dir ? s : 31 - s;
            const float er = E[(kk * 64 + pp) * 2], ei = E[(kk * 64 + pp) * 2 + 1], br = BB[(pp * 16 + j) * 2], bi = BB[(pp * 16 + j) * 2 + 1];
            Wt[tb * 65536 + (size_t)(2 * pp) * 512 + col] = (bf16)(pk2(er * br - ei * bi, 0.f) & 0xffffu);
            Wt[tb * 65536 + (size_t)(2 * pp + 1) * 512 + col] = (bf16)(pk2(er * bi + ei * br, 0.f) & 0xffffu);
        }
        for (int i = tid; i < 512 * 64; i += NTHREADS) {
            const int row = i >> 6, pp = i & 63, t = row >> 4, ci = row & 15, e = dir ? 32 - t : t + 1;
            const float er = E[(e * 64 + pp) * 2], ei = E[(e * 64 + pp) * 2 + 1], cr = CC[(ci * 64 + pp) * 2], cim = CC[(ci * 64 + pp) * 2 + 1];
            *(unsigned*)(Zt + tb * 65536 + (size_t)row * 128 + 2 * pp) = pk2(cr * er - cim * ei, -(cr * ei + cim * er));
        }
        __syncthreads();
    }
}

__device__ __forceinline__ void s5_x(const Params& p, int tid) {
    asm volatile("" : "+v"(tid));
    const int lane = tid & 63, wid = __builtin_amdgcn_readfirstlane(tid >> 6), n = lane & 15, quad = lane >> 4;
    const bf16* U = (const bf16*)(p.ws + WS_UY); const bf16* Wt = (const bf16*)(p.ws + WS_P + P_S5_W); float* X = (float*)(p.ws + WS_P + P_S5_X);
    const int G_ = gridDim.x, bid_ = blockIdx.x, vb_ = (G_ % 8 == 0) ? (bid_ % 8) * (G_ / 8) + bid_ / 8 : bid_;
    for (int u = vb_; u < 64 * 33; u += G_) {
        const int ct = u >> 6, g = u & 63, cidx = ct * 16 + n, row0 = s5_row0(cidx);
        bf16x8 uf[16];
#pragma unroll
        for (int ks = 0; ks < 16; ++ks) uf[ks] = *(const bf16x8*)(U + (size_t)(row0 + 2 * ks + (quad >> 1)) * D + g * 16 + 8 * (quad & 1));
#pragma unroll
        for (int dir = 0; dir < 2; ++dir) {
            const bf16* wp = Wt + (size_t)(g * 2 + dir) * 65536 + (size_t)(16 * wid + n) * 512 + 8 * quad;
            f32x4 acc = {0.f, 0.f, 0.f, 0.f};
#pragma unroll
            for (int ks = 0; ks < 16; ++ks) acc = mfma16(*(const bf16x8*)(wp + ks * 32), uf[ks], acc);
            *(f32x4*)(X + ((size_t)(g * 2 + dir) * 528 + cidx) * 128 + 16 * wid + 4 * quad) = acc;
        }
    }
}
__device__ __forceinline__ void s5_scan(const Params& p, int gtid) {
    if (gtid >= 131072) return;
    const int seg = gtid & 7, pp = (gtid >> 3) & 63, dir = (gtid >> 9) & 1, g = (gtid >> 10) & 63, b = gtid >> 16;
    const float* X = (const float*)(p.ws + WS_P + P_S5_X) + (size_t)(g * 2 + dir) * 528 * 128 + 2 * pp;
    bf16* Hs = (bf16*)(p.ws + WS_P + P_S5_H) + (size_t)(g * 2 + dir) * 528 * 128 + 2 * pp;
    const float* A32 = (const float*)(p.ws + WS_A32) + (size_t)(g * 2 + dir) * 128 + 2 * pp;
    const float ar = A32[0], ai = A32[1];
    f32x2 xv[33];
#pragma unroll
    for (int k = 0; k < 33; ++k) {
        const int st = seg * 33 + k;
        const int cl = dir ? (st < 8 ? 7 - st : 263 - (st - 8)) : st;
        xv[k] = *(const f32x2*)(X + (size_t)(b * 264 + cl) * 128);
    }
    float er = 0.f, ei = 0.f, pr = 1.f, pi = 0.f;
#pragma unroll
    for (int k = 0; k < 33; ++k) {
        const float nr = ar * er - ai * ei + xv[k][0], ni = ar * ei + ai * er + xv[k][1]; er = nr; ei = ni;
        const float qr = ar * pr - ai * pi, qi = ar * pi + ai * pr; pr = qr; pi = qi;
    }
    float hr = 0.f, hi = 0.f;
    const int lane = threadIdx.x & 63, lbase = lane & ~7;
#pragma unroll
    for (int j = 0; j < 7; ++j) {
        const float tr_ = __shfl(er, lbase + j), ti_ = __shfl(ei, lbase + j);
        if (j < seg) { const float nr = pr * hr - pi * hi + tr_, ni = pr * hi + pi * hr + ti_; hr = nr; hi = ni; }
    }
#pragma unroll
    for (int k = 0; k < 33; ++k) {
        const int st = seg * 33 + k;
        const int cl = dir ? (st < 8 ? 7 - st : 263 - (st - 8)) : st;
        *(unsigned*)(Hs + (size_t)(b * 264 + cl) * 128) = pk2(hr, hi);
        const float nr = ar * hr - ai * hi + xv[k][0], ni = ar * hi + ai * hr + xv[k][1]; hr = nr; hi = ni;
    }
}
__device__ __forceinline__ void s5_y(const Params& p, ldsp lds, int tid) {
    asm volatile("" : "+v"(tid));
    const int lane = tid & 63, wid = __builtin_amdgcn_readfirstlane(tid >> 6), n = lane & 15, quad = lane >> 4;
    const bf16* U = (const bf16*)(p.ws + WS_UY); const bf16* Mt = (const bf16*)(p.ws + WS_P + P_S5_M); const bf16* Zt = (const bf16*)(p.ws + WS_P + P_S5_Z);
    const bf16* Hs = (const bf16*)(p.ws + WS_P + P_S5_H); bf16* Og = (bf16*)(p.ws + WS_P + P_S5_O);
    const float* dsk = p.in[I_SD];
    for (int i = tid; i < 2 * 1024; i += NTHREADS) *(LAS u32x4*)(lds + (i >> 10) * 32768 + (i & 1023) * 16) = (u32x4){0u, 0u, 0u, 0u};
    const int G_ = gridDim.x, bid_ = blockIdx.x, vb_ = (G_ % 8 == 0) ? (bid_ % 8) * (G_ / 8) + bid_ / 8 : bid_;
    for (int u = vb_; u < 64 * 33; u += G_) {
        const int ct = u >> 6, g = u & 63, cidx = ct * 16 + n, row0 = s5_row0(cidx);
        __syncthreads();
        for (int i = tid; i < 2 * 1024; i += NTHREADS) { const int dir = i >> 10, c = i & 1023;
            *(LAS u32x4*)(lds + dir * 32768 + 16384 + c * 16) = *(const u32x4*)(Mt + (size_t)(g * 2 + dir) * 8448 + 256 + (size_t)c * 8); }
        bf16x8 uf[16], hf[2][4];
#pragma unroll
        for (int ks = 0; ks < 16; ++ks) uf[ks] = *(const bf16x8*)(U + (size_t)(row0 + 2 * ks + (quad >> 1)) * D + g * 16 + 8 * (quad & 1));
#pragma unroll
        for (int dir = 0; dir < 2; ++dir)
#pragma unroll
            for (int kk = 0; kk < 4; ++kk) hf[dir][kk] = *(const bf16x8*)(Hs + ((size_t)(g * 2 + dir) * 528 + cidx) * 128 + kk * 32 + 8 * quad);
        __syncthreads();
        for (int tt = 0; tt < 4; ++tt) {
            const int t = wid * 4 + tt;
            f32x4 acc = {0.f, 0.f, 0.f, 0.f};
            cldsp mf = lds + (t + 32 - (quad >> 1)) * 512 + n * 32 + (quad & 1) * 16;
            cldsp mb = lds + 32768 + (32 - t + (quad >> 1)) * 512 + n * 32 + (quad & 1) * 16;
#pragma unroll
            for (int ks = 0; ks < 16; ++ks) {
                if (2 * ks <= t) acc = mfma16(*(const LAS bf16x8*)(mf - ks * 1024), uf[ks], acc);
                if (2 * ks + 1 >= t) acc = mfma16(*(const LAS bf16x8*)(mb + ks * 1024), uf[ks], acc);
            }
#pragma unroll
            for (int dir = 0; dir < 2; ++dir)
#pragma unroll
                for (int kk = 0; kk < 4; ++kk)
                    acc = mfma16(*(const bf16x8*)(Zt + (size_t)(g * 2 + dir) * 65536 + (size_t)(t * 16 + n) * 128 + kk * 32 + 8 * quad), hf[dir][kk], acc);
            const size_t off = (size_t)(row0 + t) * D + g * 16 + 4 * quad;
            const u32x2 uw = *(const u32x2*)(U + off);
            const f32x4 dv = *(const f32x4*)(dsk + g * 16 + 4 * quad);
            const float y0 = acc[0] + dv[0] * bflo(uw.x), y1 = acc[1] + dv[1] * bfhi(uw.x), y2 = acc[2] + dv[2] * bflo(uw.y), y3 = acc[3] + dv[3] * bfhi(uw.y);
            u32x2 w; w.x = pk2(gelu_tanh(y0), gelu_tanh(y1)); w.y = pk2(gelu_tanh(y2), gelu_tanh(y3));
            *(u32x2*)(Og + off) = w;
        }
    }
}


#define PHASE_BEGIN if (ph >= p.ph_lo && ph < p.ph_hi) {
#define PHASE_END   if (ph + 1 < p.ph_hi) { if (ph == 0) grid.sync(); else xcd_barrier(bar); } } ++ph;
template <int L> __device__ __forceinline__ void layer_body(const Params& p, cg::grid_group& grid, const XcdBarrier& bar, ldsp lds, int& ph) {
    const int tid = threadIdx.x, lane = tid & 63, wave = __builtin_amdgcn_readfirstlane(tid >> 6);
    const int G = gridDim.x;
    const int gw = blockIdx.x * 8 + wave, ngw = G * 8;
    const int gtid = blockIdx.x * NTHREADS + tid;
    bf16* Wb = (bf16*)(p.ws + WS_W);
    bf16* UY = (bf16*)(p.ws + WS_UY);
    unsigned char* Pr = p.ws + WS_P;
    const float* normg = p.in[I_NORMG];
    (void)gtid; (void)lane;

        constexpr int l = L; constexpr int kind = L % 3, j = L / 3;
        constexpr bool last = (L == 3);
        constexpr int Mrows = last ? ML : MT;
        if constexpr (kind == 0) {
            PHASE_BEGIN
                EpiAttnIn E{(bf16*)Pr, (const float*)(p.ws + WS_ROPEA)};
                run_gemm(lds, UY, Wb + W_IN, MT, 3072, D, E);
            PHASE_END
            PHASE_BEGIN
                attn_phase(lds, (const bf16*)Pr, (bf16*)(Pr + P_ATT_O), p.in[I_ALAM] + j * 256, p.in[I_ASUBLN] + j * 128, 0.8f - 0.6f * expf(-0.3f * (float)l), !last);
            PHASE_END
            PHASE_BEGIN
                EpiStore E{UY, D};
                run_gemm(lds, (const bf16*)(Pr + P_ATT_O), Wb + W_OUT, ML, D, D, E);
                if (!last) ctx_gemm<1024>(lds, (const bf16*)(Pr + P_ATT_O), Wb + W_OUT, UY);
            PHASE_END
        } else if constexpr (kind == 1) {
            PHASE_BEGIN
                EpiRetIn E{(bf16*)Pr, (const float*)(p.ws + WS_ROPER)};
                run_gemm(lds, UY, Wb + W_IN, MT, 4096, D, E);
            PHASE_END
            PHASE_BEGIN
                retn_rb(lds, (const bf16*)Pr, (bf16*)(Pr + P_RET_OF), (bf16*)(Pr + P_RET_OB), p.in[I_RDECAY]);
            PHASE_END
            PHASE_BEGIN
                retn_ra(lds, (const bf16*)Pr, (bf16*)(Pr + P_RET_OF), (const bf16*)(Pr + P_RET_OB), p.in[I_RDECAY]);
            PHASE_END
            PHASE_BEGIN
                EpiRetGate E{(bf16*)(Pr + P_RET_OF), 2048};
                run_gemm(lds, UY, Wb + W_G, MT, 2048, D, E);
            PHASE_END
            PHASE_BEGIN
                EpiStore E{UY, D};
                run_gemm(lds, (const bf16*)(Pr + P_RET_OF), Wb + W_OUT, ML, D, 2048, E);
                if (!last) ctx_gemm<2048>(lds, (const bf16*)(Pr + P_RET_OF), Wb + W_OUT, UY);
            PHASE_END
        } else {
            PHASE_BEGIN
                s5_x(p, tid);
            PHASE_END
            PHASE_BEGIN
                s5_scan(p, gtid);
                conv_layer(p, 2, lds, gw, ngw, lane, wave);
            PHASE_END
            PHASE_BEGIN
                s5_y(p, lds, tid);
            PHASE_END
            PHASE_BEGIN
                EpiPair<1> E{UY, D};
                run_gemm(lds, (const bf16*)(Pr + P_S5_O), Wb + W_OUT, Mrows, 2048, D, E);
            PHASE_END
        }
        PHASE_BEGIN
            rows_phase(p, 1, Mrows, normg + l * 4096 + 1 * 1024, l, 2, true, normg + l * 4096 + 2 * 1024, l, 3, gw, ngw, lane);
        PHASE_END
        PHASE_BEGIN
            EpiPair<0> E{(bf16*)Pr, FF};
            run_gemm(lds, UY, Wb + W_GU, Mrows, 2 * FF, D, E);
        PHASE_END
        PHASE_BEGIN
            EpiStore E{UY, D};
            run_gemm(lds, (const bf16*)Pr, Wb + W_DN, ML, D, FF, E);
            if (!last) ctx_gemm<FF>(lds, (const bf16*)Pr, Wb + W_DN, UY);
        PHASE_END
        PHASE_BEGIN
            rows_phase(p, 1, Mrows, normg + l * 4096 + 3 * 1024, l, 5, !last, normg + (last ? 0 : (l + 1) * 4096), last ? 0 : l + 1, 0, gw, ngw, lane, last);
            if (!last) {
                __syncthreads();
                if (l != 1) conv_layer(p, l + 1, lds, gw, ngw, lane, wave);
                if (l == 1) { __syncthreads(); s5_tables(p, lds, tid); }
            }
        PHASE_END
    }
__global__ void __launch_bounds__(NTHREADS, 2) fwd_megakernel(Params p) {
    extern __shared__ __attribute__((aligned(16))) unsigned char lds_raw[];
    cg::grid_group grid = cg::this_grid();
    ldsp lds = (ldsp)lds_raw;
    const int tid = threadIdx.x, lane = tid & 63, wave = __builtin_amdgcn_readfirstlane(tid >> 6);
    const int G = gridDim.x;
    const int gw = blockIdx.x * 8 + wave, ngw = G * 8;
    const int gtid = blockIdx.x * NTHREADS + tid, ngt = G * NTHREADS;
    bf16* Wb = (bf16*)(p.ws + WS_W);
    bf16* UY = (bf16*)(p.ws + WS_UY);
    unsigned char* Pr = p.ws + WS_P;
    const float* normg = p.in[I_NORMG];
    int ph = 0;
    if (tid < 16) ((LAS unsigned*)(lds + LDS_BYTES - 64))[tid] = 0u;
    __syncthreads();
    const XcdBarrier bar = xcd_barrier_post((unsigned*)(p.ws + WS_BAR), (volatile LAS unsigned*)(lds + LDS_BYTES - 64));

    PHASE_BEGIN
        mods_phase(p, lds, tid);
        rope_tables(p, gtid, ngt);
        __syncthreads();
        conv_layer(p, 0, lds, gw, ngw, lane, wave);
    PHASE_END
    PHASE_BEGIN
        rows_phase(p, 0, MT, nullptr, 0, 0, true, normg + 0 * 4096 + 0 * 1024, 0, 0, gw, ngw, lane);
    PHASE_END
    layer_body<0>(p, grid, bar, lds, ph);
    layer_body<1>(p, grid, bar, lds, ph);
    layer_body<2>(p, grid, bar, lds, ph);
    layer_body<3>(p, grid, bar, lds, ph);
#undef PHASE_BEGIN
#undef PHASE_END
}

extern "C" void kernel_launch(void* const* d_in, const int* in_sizes, int n_in, void* d_out, int out_size, void* d_ws, size_t ws_size, hipStream_t stream) {
    static int grid_blocks = 0;
    if (grid_blocks == 0) {
        if (n_in != 26 || out_size != ML * D || ws_size < WS_END) { fprintf(stderr, "kernel_launch: unexpected shapes (n_in %d out %d ws %zu need %zu)\n", n_in, out_size, ws_size, (size_t)WS_END); grid_blocks = -1; return; }
        int dev = 0, cus = 0, per_cu = 0;
        hipGetDevice(&dev);
        hipDeviceGetAttribute(&cus, hipDeviceAttributeMultiprocessorCount, dev);
        hipFuncSetAttribute((const void*)fwd_megakernel, hipFuncAttributeMaxDynamicSharedMemorySize, LDS_BYTES);
        hipOccupancyMaxActiveBlocksPerMultiprocessor(&per_cu, (const void*)fwd_megakernel, NTHREADS, LDS_BYTES);
        if (per_cu < 1) { fprintf(stderr, "kernel_launch: occupancy query returned %d\n", per_cu); per_cu = 1; }
        (void)hipGetLastError();
        grid_blocks = cus;
    }
    if (grid_blocks < 0) return;
    Params p{};
    for (int i = 0; i < 26; ++i) p.in[i] = (const float*)d_in[i];
    p.out = (float*)d_out; p.ws = (unsigned char*)d_ws; p.ph_lo = 0; p.ph_hi = 1000;
    if (hipMemsetAsync((char*)d_ws + WS_BAR, 0, 16384, stream) != hipSuccess) { fprintf(stderr, "kernel_launch: memset failed\n"); return; }
    void* args[] = {&p};
    hipError_t e = hipLaunchCooperativeKernel((const void*)fwd_megakernel, dim3(grid_blocks), dim3(NTHREADS), args, LDS_BYTES, stream);
    if (e != hipSuccess) fprintf(stderr, "cooperative launch failed: %s (grid %d)\n", hipGetErrorString(e), grid_blocks);
}
```
